# Optimizing an MI355X kernel written in HIP

```python
import math
import jax
import jax.numpy as jnp
from jax import lax
import numpy as np

D_MODEL = 1024
BATCH = 4
SEQ = 8192
DEPTH = 2

GRID_W = 64
CTX_LEN = 256
EPS = 1e-6
F32 = jnp.float32
HEAD_DIM = 64
GROUP_W = D_MODEL // 2
D_FF = 256 * ((8 * D_MODEL // 3 + 255) // 256)
N_MOD = 9

NA_HEADS = GROUP_W // HEAD_DIM
NA_WIN_R = 8
NA_WIN_C = 16
NA_QBLK = 16
NA_STRIP = NA_QBLK + NA_WIN_C

SSD_HEADS = GROUP_W // HEAD_DIM
SSD_P = HEAD_DIM
SSD_GROUPS = 2
SSD_STATE = 128
SSD_CONV = 4
SSD_CHUNK = 128
SSD_CONV_CH = GROUP_W + 2 * SSD_GROUPS * SSD_STATE

LRU_W = GROUP_W
LRU_BLOCKS = LRU_W // HEAD_DIM
LRU_BS = LRU_W // LRU_BLOCKS
LRU_CONV = 4
LRU_C = 8.0

DIFF_HEADS = GROUP_W // (2 * HEAD_DIM)
DIFF_QBLK = 128
ROPE_BASE = 10000.0

AB_SPLITS = (GROUP_W, GROUP_W, GROUP_W, GROUP_W, SSD_CONV_CH, 2 * SSD_HEADS)
AB_IN = sum(AB_SPLITS)
CD_SPLITS = (LRU_W, LRU_W, GROUP_W, GROUP_W, GROUP_W)
CD_IN = sum(CD_SPLITS)

kernel_name = 'hybrid_na_ssd_rglru_diffattn_prefix_dit'


def _split(u, sizes):
    return jnp.split(u, [int(s) for s in np.cumsum(sizes)[:-1]], axis=-1)


def rms_norm(x, g):
    xf = x.astype(F32)
    y = xf * lax.rsqrt(jnp.mean(xf * xf, axis=-1, keepdims=True) + EPS)
    return (y * g.astype(F32)).astype(x.dtype)


def _modulate(h, g, m, k):
    return (rms_norm(h, g) * (1 + m[:, :, 3 * k + 1]) + m[:, :, 3 * k]).astype(h.dtype)


def swiglu(h, w1, w3, w2):
    return (jax.nn.silu(h @ w1) * (h @ w3)) @ w2


def _half_ffn(h, g, m, k, w1, w3, w2):
    y = swiglu(_modulate(h, g, m, k), w1, w3, w2)
    return h + (0.5 * m[:, :, 3 * k + 2] * y).astype(h.dtype)


def dwconv_centred(x, w, b):
    K, C = w.shape
    left = K // 2
    y = lax.conv_general_dilated(x, w[:, None, :].astype(x.dtype), window_strides=(1,),
                                 padding=[(left, K - 1 - left)],
                                 dimension_numbers=('NWC', 'WIO', 'NWC'), feature_group_count=C)
    return y + b.astype(x.dtype)


def axial_rope(L, d):
    t = jnp.arange(L)
    row = (t // GRID_W).astype(F32)
    col = (t % GRID_W).astype(F32)
    n = d // 4
    inv = ROPE_BASE ** (-jnp.arange(n, dtype=F32) / n)
    ang = jnp.concatenate([row[:, None] * inv, col[:, None] * inv], axis=-1)
    return jnp.cos(ang), jnp.sin(ang)


def apply_rope(x, cos, sin):
    L = x.shape[1]
    shp = (1, L) + (1,) * (x.ndim - 3) + (cos.shape[-1],)
    cs, sn = cos.reshape(shp), sin.reshape(shp)
    xr = x.astype(F32).reshape(x.shape[:-1] + (-1, 2))
    x1, x2 = xr[..., 0], xr[..., 1]
    out = jnp.stack([x1 * cs - x2 * sn, x1 * sn + x2 * cs], axis=-1)
    return out.reshape(x.shape).astype(x.dtype)


def softmax_attn(q, k, v):
    s = jnp.einsum('bqhd,bkhd->bhqk', q, k, preferred_element_type=F32) * (q.shape[-1] ** -0.5)
    p = jax.nn.softmax(s, axis=-1)
    return jnp.einsum('bhqk,bkhd->bqhd', p, v.astype(F32)).astype(q.dtype)


def neighborhood_attention(q, k, v, kc, vc, rpb):
    Bsz, S, H, d = q.shape
    rows = S // GRID_W
    kr = min(NA_WIN_R, rows)
    ncb = GRID_W // NA_QBLK
    scale = d ** -0.5
    qcols = jnp.arange(GRID_W).reshape(ncb, NA_QBLK)
    qc0 = jnp.clip(qcols - NA_WIN_C // 2, 0, GRID_W - NA_WIN_C)
    strip0 = jnp.clip(jnp.arange(ncb) * NA_QBLK - NA_WIN_C // 2, 0, GRID_W - NA_STRIP)
    strip_cols = strip0[:, None] + jnp.arange(NA_STRIP)[None, :]
    kcol = strip_cols[:, None, :]
    col_in = (kcol >= qc0[..., None]) & (kcol < qc0[..., None] + NA_WIN_C)
    dc = jnp.clip(kcol - qcols[..., None] + NA_WIN_C - 1, 0, 2 * NA_WIN_C - 2)
    mask = col_in[None, None, :, :, None, :]

    def row_block(args):
        q_row, r = args
        r0 = jnp.clip(r - kr // 2, 0, rows - kr)
        k_rows = lax.dynamic_slice_in_dim(k, r0 * GRID_W, kr * GRID_W, axis=1).reshape(Bsz, kr, GRID_W, H, d)
        v_rows = lax.dynamic_slice_in_dim(v, r0 * GRID_W, kr * GRID_W, axis=1).reshape(Bsz, kr, GRID_W, H, d)
        k_s = jnp.take(k_rows, strip_cols, axis=2)
        v_s = jnp.take(v_rows, strip_cols, axis=2)
        qb = q_row.reshape(Bsz, ncb, NA_QBLK, H, d)
        dr = r0 + jnp.arange(kr) - r + NA_WIN_R - 1
        bias = rpb[:, dr[:, None, None, None], dc[None]].transpose(0, 2, 3, 1, 4)
        s_lat = jnp.einsum('bnqhd,bknshd->bhnqks', qb, k_s, preferred_element_type=F32) * scale + bias[None].astype(F32)
        s_lat = jnp.where(mask, s_lat, -jnp.inf).reshape(Bsz, H, ncb, NA_QBLK, kr * NA_STRIP)
        s_ctx = jnp.einsum('bnqhd,bchd->bhnqc', qb, kc, preferred_element_type=F32) * scale
        p = jax.nn.softmax(jnp.concatenate([s_lat, s_ctx], axis=-1), axis=-1)
        p_lat = p[..., :kr * NA_STRIP].reshape(Bsz, H, ncb, NA_QBLK, kr, NA_STRIP)
        p_ctx = p[..., kr * NA_STRIP:]
        o = (jnp.einsum('bhnqks,bknshd->bnqhd', p_lat, v_s.astype(F32))
             + jnp.einsum('bhnqc,bchd->bnqhd', p_ctx, vc.astype(F32)))
        return o.reshape(Bsz, GRID_W, H, d).astype(q.dtype)

    q_rows = jnp.moveaxis(q.reshape(Bsz, rows, GRID_W, H, d), 1, 0)
    o = lax.map(row_block, (q_rows, jnp.arange(rows)))
    return jnp.moveaxis(o, 0, 1).reshape(Bsz, S, H, d)


def ssd_scan(x, dt, A, Bm, Cm, h0):
    Bsz, L, H, P = x.shape
    G, N = Bm.shape[2], Bm.shape[3]
    R = H // G
    Q = SSD_CHUNK
    nc = L // Q
    x = x.astype(F32).reshape(Bsz, nc, Q, G, R, P)
    dt = dt.reshape(Bsz, nc, Q, G, R)
    Bm = Bm.astype(F32).reshape(Bsz, nc, Q, G, N)
    Cm = Cm.astype(F32).reshape(Bsz, nc, Q, G, N)
    a_cs = jnp.cumsum(dt * A.reshape(G, R), axis=2).transpose(0, 1, 3, 4, 2)
    tri = jnp.tril(jnp.ones((Q, Q), dtype=bool))
    decay_in = jnp.exp(jnp.where(tri, a_cs[..., :, None] - a_cs[..., None, :], -jnp.inf))
    xdt = x * dt[..., None]
    cb = jnp.einsum('bcign,bcjgn->bcgij', Cm, Bm)
    y_diag = jnp.einsum('bcgij,bcgrij,bcjgrp->bcigrp', cb, decay_in, xdt)
    decay_end = jnp.exp(a_cs[..., -1:] - a_cs)
    states = jnp.einsum('bcjgn,bcgrj,bcjgrp->bcgrpn', Bm, decay_end, xdt)
    chunk_decay = jnp.exp(a_cs[..., -1])

    def step(h, inp):
        s, dcy = inp
        return h * dcy[..., None, None] + s, h

    h_last, h_start = lax.scan(step, h0.astype(F32).reshape(Bsz, G, R, P, N),
                               (jnp.moveaxis(states, 1, 0), jnp.moveaxis(chunk_decay, 1, 0)))
    h_start = jnp.moveaxis(h_start, 0, 1)
    y_off = jnp.einsum('bcign,bcgrpn,bcgri->bcigrp', Cm, h_start, jnp.exp(a_cs))
    y = (y_diag + y_off).reshape(Bsz, L, H, P)
    return y, h_last.reshape(Bsz, H, P, N)


def ssd_branch(xbc, dt_raw, conv_w, conv_b, dt_bias, a_log, d_skip, h0_f, h0_b):
    Bsz, L, _ = xbc.shape
    xbc = jax.nn.silu(dwconv_centred(xbc, conv_w, conv_b))
    xs, bm, cm = _split(xbc, (GROUP_W, SSD_GROUPS * SSD_STATE, SSD_GROUPS * SSD_STATE))
    xs = xs.reshape(Bsz, L, SSD_HEADS, SSD_P)
    bm = bm.reshape(Bsz, L, SSD_GROUPS, SSD_STATE)
    cm = cm.reshape(Bsz, L, SSD_GROUPS, SSD_STATE)
    dt = jax.nn.softplus(dt_raw.astype(F32).reshape(Bsz, L, 2, SSD_HEADS) + dt_bias.astype(F32))
    A = -jnp.exp(a_log.astype(F32))
    flip = lambda t: jnp.flip(t, axis=1)
    y_f, hf = ssd_scan(xs, dt[:, :, 0], A[0], bm, cm, h0_f)
    y_b, hb = ssd_scan(flip(xs), flip(dt[:, :, 1]), A[1], flip(bm), flip(cm), h0_b)
    y = y_f + flip(y_b) + d_skip.astype(F32)[:, None] * xs.astype(F32)
    return y, hf, hb


def rglru_scan(x, wa, ba, wx, bx, lam, h0):
    Bsz, L, W = x.shape
    xf = x.astype(F32)
    xb = xf.reshape(Bsz, L, LRU_BLOCKS, LRU_BS)
    r = jax.nn.sigmoid(jnp.einsum('blnd,nde->blne', xb, wa.astype(F32)).reshape(Bsz, L, W) + ba.astype(F32))
    i = jax.nn.sigmoid(jnp.einsum('blnd,nde->blne', xb, wx.astype(F32)).reshape(Bsz, L, W) + bx.astype(F32))
    log_a = -LRU_C * r * jax.nn.softplus(-lam.astype(F32))
    a = jnp.exp(log_a)
    b = jnp.sqrt(-jnp.expm1(2 * log_a)) * (i * xf)
    b = b.at[:, 0].add(a[:, 0] * h0)

    def combine(u, v):
        return u[0] * v[0], v[0] * u[1] + v[1]

    _, h = lax.associative_scan(combine, (a, b), axis=1)
    return h, h[:, -1]


def rglru_bidir(x, wa, ba, wx, bx, lam, h0_f, h0_b):
    h_f, last_f = rglru_scan(x, wa[0], ba[0], wx[0], bx[0], lam[0], h0_f)
    h_b, last_b = rglru_scan(jnp.flip(x, axis=1), wa[1], ba[1], wx[1], bx[1], lam[1], h0_b)
    return h_f + jnp.flip(h_b, axis=1), last_f, last_b


def diff_attn_core(qb, k, v, lam):
    s = jnp.einsum('bqhtd,bkhtd->bhtqk', qb, k, preferred_element_type=F32) * (qb.shape[-1] ** -0.5)
    p = jax.nn.softmax(s, axis=-1)
    w = p[:, :, 0] - lam * p[:, :, 1]
    return jnp.einsum('bhqk,bkhe->bqhe', w, v.astype(F32))


def mixer_ab(hx, hc, w_in, w_out, q_g, k_g, rpb, conv_w, conv_b, dt_bias, a_log, d_skip, norm_g, with_ctx):
    Bsz, S, _ = hx.shape
    Lc = hc.shape[1]
    q, k, v, z, xbc, dt = _split(hx @ w_in, AB_SPLITS)
    q_c, k_c, v_c, z_c, xbc_c, dt_c = _split(hc @ w_in, AB_SPLITS)

    def heads(q, k, v):
        shp = (Bsz, q.shape[1], NA_HEADS, HEAD_DIM)
        return rms_norm(q.reshape(shp), q_g), rms_norm(k.reshape(shp), k_g), v.reshape(shp)

    q, k, v = heads(q, k, v)
    q_c, k_c, v_c = heads(q_c, k_c, v_c)
    o_na = neighborhood_attention(q, k, v, k_c, v_c, rpb)

    zeros = jnp.zeros((Bsz, SSD_HEADS, SSD_P, SSD_STATE), F32)
    y_c, hf_c, hb_c = ssd_branch(xbc_c, dt_c, conv_w, conv_b, dt_bias, a_log, d_skip, zeros, zeros)
    y_s, _, _ = ssd_branch(xbc, dt, conv_w, conv_b, dt_bias, a_log, d_skip, hf_c, hb_c)

    def gated(y, zz):
        return rms_norm(y.reshape(Bsz, y.shape[1], GROUP_W) * jax.nn.silu(zz.astype(F32)), norm_g).astype(hx.dtype)

    y = jnp.concatenate([o_na.reshape(Bsz, S, GROUP_W), gated(y_s, z)], axis=-1) @ w_out
    yc = None
    if with_ctx:
        o_c = softmax_attn(q_c, k_c, v_c)
        yc = jnp.concatenate([o_c.reshape(Bsz, Lc, GROUP_W), gated(y_c, z_c)], axis=-1) @ w_out
    return y, yc


def mixer_cd(hx, hc, w_in, w_out, conv_w, conv_b, wa, ba, wx, bx, lam_p, q_g, k_g, diff_lam, subln_g, lam_init, with_ctx):
    Bsz, S, _ = hx.shape
    Lc = hc.shape[1]
    gate, xr, q, k, v = _split(hx @ w_in, CD_SPLITS)
    gate_c, xr_c, q_c, k_c, v_c = _split(hc @ w_in, CD_SPLITS)

    xr_c = dwconv_centred(xr_c, conv_w, conv_b)
    xr = dwconv_centred(xr, conv_w, conv_b)
    zeros = jnp.zeros((Bsz, LRU_W), F32)
    h_c, hf_c, hb_c = rglru_bidir(xr_c, wa, ba, wx, bx, lam_p, zeros, zeros)
    h, _, _ = rglru_bidir(xr, wa, ba, wx, bx, lam_p, hf_c, hb_c)
    out_c = (jax.nn.gelu(gate.astype(F32)) * h).astype(hx.dtype)

    lam = (jnp.exp(jnp.sum(diff_lam[0].astype(F32) * diff_lam[1].astype(F32)))
           - jnp.exp(jnp.sum(diff_lam[2].astype(F32) * diff_lam[3].astype(F32))) + lam_init)

    def heads(q, k, v):
        L = q.shape[1]
        shp = (Bsz, L, DIFF_HEADS, 2, HEAD_DIM)
        return (rms_norm(q.reshape(shp), q_g), rms_norm(k.reshape(shp), k_g),
                v.reshape(Bsz, L, DIFF_HEADS, 2 * HEAD_DIM))

    q, k, v = heads(q, k, v)
    q_c, k_c, v_c = heads(q_c, k_c, v_c)
    cos, sin = axial_rope(S, HEAD_DIM)
    q = apply_rope(q, cos, sin)
    k = apply_rope(k, cos, sin)
    k_all = jnp.concatenate([k_c, k], axis=1)
    v_all = jnp.concatenate([v_c, v], axis=1)
    nb = S // DIFF_QBLK
    q_blocks = jnp.moveaxis(q.reshape(Bsz, nb, DIFF_QBLK, DIFF_HEADS, 2, HEAD_DIM), 1, 0)
    o = lax.map(lambda qb: diff_attn_core(qb, k_all, v_all, lam), q_blocks)
    o = jnp.moveaxis(o, 0, 1).reshape(Bsz, S, DIFF_HEADS, 2 * HEAD_DIM)
    o = (rms_norm(o, subln_g) * (1 - lam_init)).reshape(Bsz, S, GROUP_W).astype(hx.dtype)
    y = jnp.concatenate([out_c, o], axis=-1) @ w_out
    yc = None
    if with_ctx:
        oc = diff_attn_core(q_c, k_c, v_c, lam)
        oc = (rms_norm(oc, subln_g) * (1 - lam_init)).reshape(Bsz, Lc, GROUP_W).astype(hc.dtype)
        oc_lru = (jax.nn.gelu(gate_c.astype(F32)) * h_c).astype(hc.dtype)
        yc = jnp.concatenate([oc_lru, oc], axis=-1) @ w_out
    return y, yc


def setup_inputs(seed: int = 0) -> dict:
    key = jax.random.key(seed)
    ks = list(jax.random.split(key, 40))
    cnt = [0]

    def nk():
        cnt[0] += 1
        return ks[cnt[0] - 1]

    def nrm(shape, s):
        return jax.random.normal(nk(), shape, F32) * s

    D = D_MODEL
    NE = (DEPTH + 1) // 2
    NO = DEPTH // 2
    x = nrm((BATCH, SEQ, D), 1.0)
    c = nrm((BATCH, D), 1.0)
    ctx = nrm((BATCH, CTX_LEN, D), 1.0)
    c_ctx = nrm((D,), 1.0)
    w_mod = nrm((DEPTH, D, N_MOD * D), 0.5 * D ** -0.5)
    b_mod = nrm((DEPTH, N_MOD * D), 0.01)
    norm_g = 1.0 + nrm((DEPTH, 3, D), 0.02)
    ffn_w1 = nrm((DEPTH, 2, D, D_FF), D ** -0.5)
    ffn_w3 = nrm((DEPTH, 2, D, D_FF), D ** -0.5)
    ffn_w2 = nrm((DEPTH, 2, D_FF, D), D_FF ** -0.5)
    ab_w_in = nrm((NE, D, AB_IN), D ** -0.5)
    ab_w_out = nrm((NE, 2 * GROUP_W, D), (2 * GROUP_W) ** -0.5)
    na_q_g = 1.0 + nrm((NE, HEAD_DIM), 0.02)
    na_k_g = 1.0 + nrm((NE, HEAD_DIM), 0.02)
    na_rpb = nrm((NE, NA_HEADS, 2 * NA_WIN_R - 1, 2 * NA_WIN_C - 1), 0.2)
    ssd_conv_w = nrm((NE, SSD_CONV, SSD_CONV_CH), SSD_CONV ** -0.5)
    ssd_conv_b = nrm((NE, SSD_CONV_CH), 0.01)
    dt0 = jnp.exp(jax.random.uniform(nk(), (NE, 2, SSD_HEADS), F32, math.log(1e-3), math.log(1e-1)))
    ssd_dt_bias = dt0 + jnp.log(-jnp.expm1(-dt0))
    ssd_a_log = jnp.log(jax.random.uniform(nk(), (NE, 2, SSD_HEADS), F32, 1.0, 16.0))
    ssd_d = 1.0 + nrm((NE, SSD_HEADS), 0.1)
    ssd_norm_g = 1.0 + nrm((NE, GROUP_W), 0.02)
    cd_w_in = nrm((NO, D, CD_IN), D ** -0.5)
    cd_w_out = nrm((NO, 2 * GROUP_W, D), (2 * GROUP_W) ** -0.5)
    lru_conv_w = nrm((NO, LRU_CONV, LRU_W), LRU_CONV ** -0.5)
    lru_conv_b = nrm((NO, LRU_W), 0.01)
    lru_wa = nrm((NO, 2, LRU_BLOCKS, LRU_BS, LRU_BS), LRU_BS ** -0.5)
    lru_ba = nrm((NO, 2, LRU_W), 0.1)
    lru_wx = nrm((NO, 2, LRU_BLOCKS, LRU_BS, LRU_BS), LRU_BS ** -0.5)
    lru_bx = nrm((NO, 2, LRU_W), 0.1)
    u = jax.random.uniform(nk(), (NO, 2, LRU_W), F32, 0.9, 0.999) ** (1.0 / LRU_C)
    lru_lambda = jnp.log(u) - jnp.log1p(-u)
    diff_q_g = 1.0 + nrm((NO, HEAD_DIM), 0.02)
    diff_k_g = 1.0 + nrm((NO, HEAD_DIM), 0.02)
    diff_lambda = nrm((NO, 4, HEAD_DIM), 0.1)
    diff_subln_g = 1.0 + nrm((NO, 2 * HEAD_DIM), 0.02)
    return {'x': x, 'c': c, 'ctx': ctx, 'c_ctx': c_ctx, 'w_mod': w_mod, 'b_mod': b_mod, 'norm_g': norm_g,
            'ffn_w1': ffn_w1, 'ffn_w3': ffn_w3, 'ffn_w2': ffn_w2, 'ab_w_in': ab_w_in, 'ab_w_out': ab_w_out,
            'na_q_g': na_q_g, 'na_k_g': na_k_g, 'na_rpb': na_rpb, 'ssd_conv_w': ssd_conv_w,
            'ssd_conv_b': ssd_conv_b, 'ssd_dt_bias': ssd_dt_bias, 'ssd_a_log': ssd_a_log, 'ssd_d': ssd_d,
            'ssd_norm_g': ssd_norm_g, 'cd_w_in': cd_w_in, 'cd_w_out': cd_w_out, 'lru_conv_w': lru_conv_w,
            'lru_conv_b': lru_conv_b, 'lru_wa': lru_wa, 'lru_ba': lru_ba, 'lru_wx': lru_wx, 'lru_bx': lru_bx,
            'lru_lambda': lru_lambda, 'diff_q_g': diff_q_g, 'diff_k_g': diff_k_g, 'diff_lambda': diff_lambda,
            'diff_subln_g': diff_subln_g}


def reference(x, c, ctx, c_ctx, w_mod, b_mod, norm_g, ffn_w1, ffn_w3, ffn_w2, ab_w_in, ab_w_out,
              na_q_g, na_k_g, na_rpb, ssd_conv_w, ssd_conv_b, ssd_dt_bias, ssd_a_log, ssd_d, ssd_norm_g,
              cd_w_in, cd_w_out, lru_conv_w, lru_conv_b, lru_wa, lru_ba, lru_wx, lru_bx, lru_lambda,
              diff_q_g, diff_k_g, diff_lambda, diff_subln_g):
    Bsz = x.shape[0]
    sc = jax.nn.silu(c.astype(F32))
    scc = jax.nn.silu(c_ctx.astype(F32))
    xc = ctx
    for i in range(DEPTH):
        last = i == DEPTH - 1
        j = i // 2
        m = (sc @ w_mod[i].astype(F32) + b_mod[i].astype(F32)).reshape(Bsz, 1, N_MOD, D_MODEL)
        mc = (scc @ w_mod[i].astype(F32) + b_mod[i].astype(F32)).reshape(1, 1, N_MOD, D_MODEL)
        x = _half_ffn(x, norm_g[i, 0], m, 0, ffn_w1[i, 0], ffn_w3[i, 0], ffn_w2[i, 0])
        xc = _half_ffn(xc, norm_g[i, 0], mc, 0, ffn_w1[i, 0], ffn_w3[i, 0], ffn_w2[i, 0])
        hx = _modulate(x, norm_g[i, 1], m, 1)
        hc = _modulate(xc, norm_g[i, 1], mc, 1)
        if i % 2 == 0:
            y, yc = mixer_ab(hx, hc, ab_w_in[j], ab_w_out[j], na_q_g[j], na_k_g[j], na_rpb[j],
                             ssd_conv_w[j], ssd_conv_b[j], ssd_dt_bias[j], ssd_a_log[j], ssd_d[j],
                             ssd_norm_g[j], not last)
        else:
            lam_init = 0.8 - 0.6 * math.exp(-0.3 * i)
            y, yc = mixer_cd(hx, hc, cd_w_in[j], cd_w_out[j], lru_conv_w[j], lru_conv_b[j], lru_wa[j],
                             lru_ba[j], lru_wx[j], lru_bx[j], lru_lambda[j], diff_q_g[j], diff_k_g[j],
                             diff_lambda[j], diff_subln_g[j], lam_init, not last)
        x = x + (m[:, :, 5] * y).astype(x.dtype)
        x = _half_ffn(x, norm_g[i, 2], m, 2, ffn_w1[i, 1], ffn_w3[i, 1], ffn_w2[i, 1])
        if not last:
            xc = xc + (mc[:, :, 5] * yc).astype(xc.dtype)
            xc = _half_ffn(xc, norm_g[i, 2], mc, 2, ffn_w1[i, 1], ffn_w3[i, 1], ffn_w2[i, 1])
    return x
```

```cpp
#include <hip/hip_runtime.h>
#include <hip/hip_cooperative_groups.h>
#include <cstdio>
namespace cg = cooperative_groups;

typedef unsigned short bf16_t;
typedef short bf16x8 __attribute__((ext_vector_type(8)));
typedef float f32x4 __attribute__((ext_vector_type(4)));
typedef float f32x16 __attribute__((ext_vector_type(16)));
typedef unsigned u32x4 __attribute__((ext_vector_type(4)));
typedef unsigned u32x2 __attribute__((ext_vector_type(2)));

#define LOG2E 1.4426950408889634f
constexpr int TL = 32768, TC = 1024, TT = TL + TC, DM = 1024, DFF = 2816;
constexpr int NT = 512;
constexpr float EPS = 1e-6f;
constexpr float LAM_INIT = 0.35550906f;

constexpr size_t al256(size_t x) { return (x + 255) & ~(size_t)255; }
constexpr size_t OFF_W13 = 0;
constexpr size_t OFF_W2 = OFF_W13 + (size_t)4 * 5632 * 1024 * 2;
constexpr size_t OFF_WABIN = OFF_W2 + (size_t)4 * 1024 * 2816 * 2;
constexpr size_t OFF_WABOUT = OFF_WABIN + (size_t)3200 * 1024 * 2;
constexpr size_t OFF_WCDIN = OFF_WABOUT + (size_t)1024 * 1024 * 2;
constexpr size_t OFF_WCDOUT = OFF_WCDIN + (size_t)2560 * 1024 * 2;
constexpr size_t OFF_WLRU = OFF_WCDOUT + (size_t)1024 * 1024 * 2;
constexpr size_t OFF_MOD = OFF_WLRU + (size_t)2 * 2 * 8 * 64 * 64 * 2;
constexpr size_t OFF_SCAL = OFF_MOD + (size_t)2 * 5 * 9216 * 4;
constexpr size_t OFF_XC = OFF_SCAL + 256;
constexpr size_t OFF_H = OFF_XC + (size_t)TC * DM * 4;
constexpr size_t OFF_BIG = OFF_H + (size_t)TT * DM * 2;
constexpr size_t OFF_DT = OFF_BIG + (size_t)TT * 3072 * 2;
constexpr size_t OFF_XBC = OFF_DT + (size_t)TT * 16 * 4;
constexpr size_t OFF_ST = OFF_XBC + (size_t)TT * 1024 * 2;
constexpr size_t OFF_DEC = OFF_ST + (size_t)4 * 2 * 8 * 66 * 64 * 128 * 2;
constexpr size_t OFF_SSQ = al256(OFF_DEC + (size_t)4 * 2 * 8 * 66 * 4);
constexpr size_t OFF_LCA = OFF_SSQ + (size_t)TT * 16 * 4;
constexpr size_t OFF_LCH = OFF_LCA + (size_t)4 * 2 * 66 * 512 * 4;
constexpr size_t OFF_LHIN = OFF_LCH + (size_t)4 * 2 * 66 * 512 * 4;
constexpr size_t WS_END = OFF_LHIN + (size_t)4 * 2 * 66 * 512 * 4;
static_assert(WS_END <= (size_t)536870912, "workspace too large");

struct Params {
  const float *x, *c, *ctx, *c_ctx, *w_mod, *b_mod, *norm_g, *ffn_w1, *ffn_w3, *ffn_w2, *ab_w_in, *ab_w_out, *na_q_g,
      *na_k_g, *na_rpb, *ssd_conv_w, *ssd_conv_b, *ssd_dt_bias, *ssd_a_log, *ssd_d, *ssd_norm_g, *cd_w_in, *cd_w_out,
      *lru_conv_w, *lru_conv_b, *lru_wa, *lru_ba, *lru_wx, *lru_bx, *lru_lambda, *diff_q_g, *diff_k_g, *diff_lambda,
      *diff_subln_g;
  float* out;
  char* ws;
};

typedef __attribute__((address_space(1))) char gchar_t;
typedef __attribute__((address_space(1))) float gfloat_t;
typedef __attribute__((address_space(1))) const float gcfloat_t;
__device__ __forceinline__ char* ws_of(char* w) { unsigned long long v = (unsigned long long)w; asm volatile("" : "+s"(v)); return (char*)(gchar_t*)v; }
__device__ __forceinline__ float* out_of(float* w) { unsigned long long v = (unsigned long long)w; asm volatile("" : "+s"(v)); return (float*)(gfloat_t*)v; }
__device__ __forceinline__ const float* prm_of(const float* w) { unsigned long long v = (unsigned long long)w; asm volatile("" : "+s"(v)); return (const float*)(gcfloat_t*)v; }
#define WSP(p) ws_of((p).ws)
#define OUTP(p) out_of((p).out)
#define PRM(p, f) prm_of((p).f)
__device__ __forceinline__ int tidx() { int t = __builtin_amdgcn_workitem_id_x(); asm volatile("" : "+v"(t)); return t; }
typedef __bf16 bf16x2_t __attribute__((ext_vector_type(2)));
typedef float f32x2_t __attribute__((ext_vector_type(2)));
__device__ __forceinline__ unsigned cvtpk(float lo, float hi) {
  f32x2_t v = {lo, hi};
  bf16x2_t b = __builtin_convertvector(v, bf16x2_t);
  return __builtin_bit_cast(unsigned, b);
}
__device__ __forceinline__ float bflo(unsigned u) { return __uint_as_float(u << 16); }
__device__ __forceinline__ float bfhi(unsigned u) { return __uint_as_float(u & 0xffff0000u); }
__device__ __forceinline__ float siluf(float v) { return v / (1.f + __expf(-v)); }
__device__ __forceinline__ float sigmf(float v) { return 1.f / (1.f + __expf(-v)); }
__device__ __forceinline__ float softplusf(float v) { return fmaxf(v, 0.f) + log1pf(__expf(-fabsf(v))); }
__device__ __forceinline__ float gelu_tanh(float v) {
  float u = 0.7978845608028654f * (v + 0.044715f * v * v * v);
  float t = 1.f - 2.f / (1.f + __expf(2.f * u));
  return 0.5f * v * (1.f + t);
}
__device__ __forceinline__ f32x16 mfma32(bf16x8 a, bf16x8 b, f32x16 c) {
  return __builtin_amdgcn_mfma_f32_32x32x16_bf16(a, b, c, 0, 0, 0);
}
__device__ __forceinline__ f32x4 mfma16(bf16x8 a, bf16x8 b, f32x4 c) {
  return __builtin_amdgcn_mfma_f32_16x16x32_bf16(a, b, c, 0, 0, 0);
}
__device__ __forceinline__ bf16x8 ldsfrag16(const char* p) { return *(const bf16x8*)p; }
__device__ __forceinline__ bf16x8 ldsfrag8x2(const char* p0, const char* p1) {
  u32x2 a = *(const u32x2*)p0, b = *(const u32x2*)p1;
  u32x4 t = {a.x, a.y, b.x, b.y};
  return __builtin_bit_cast(bf16x8, t);
}
__device__ __forceinline__ float wave_sum(float v) {
#pragma unroll
  for (int o = 32; o > 0; o >>= 1) v += __shfl_xor(v, o);
  return v;
}
__device__ __forceinline__ float wave_max(float v) {
#pragma unroll
  for (int o = 32; o > 0; o >>= 1) v = fmaxf(v, __shfl_xor(v, o));
  return v;
}
__device__ __forceinline__ int modidx(int row) { return row < TL ? (row >> 13) : 4; }
__device__ __forceinline__ float* xrow(const Params& p, int row) {
  return row < TL ? OUTP(p) + (size_t)row * DM : (float*)(WSP(p) + OFF_XC) + (size_t)(row - TL) * DM;
}
__device__ __forceinline__ const float* xinrow(const Params& p, int row) {
  return row < TL ? PRM(p, x) + (size_t)row * DM : PRM(p, ctx) + (size_t)(row - TL) * DM;
}
__device__ __forceinline__ int chunk_tok0(int b, int cc) { return cc < 2 ? TL + b * 256 + cc * 128 : b * 8192 + (cc - 2) * 128; }

template <bool SCALE>
__device__ __forceinline__ void stage_T(const bf16_t* src, int ld, int nt, int nc, char* dst, int RS, const float* wl) {
  const int nct = nc >> 2, total = (nt >> 2) * nct;
  for (int m = tidx(); m < total; m += NT) {
    const int tc = m % nct, tt = m / nct;
    const bf16_t* s = src + (size_t)(tt * 4) * ld + tc * 4;
    u32x2 v0 = *(const u32x2*)s, v1 = *(const u32x2*)(s + ld), v2 = *(const u32x2*)(s + 2 * ld), v3 = *(const u32x2*)(s + 3 * ld);
    u32x2 o0, o1, o2, o3;
    if (SCALE) {
      const float w0 = wl[tt * 4], w1 = wl[tt * 4 + 1], w2 = wl[tt * 4 + 2], w3 = wl[tt * 4 + 3];
      o0.x = cvtpk(bflo(v0.x) * w0, bflo(v1.x) * w1); o0.y = cvtpk(bflo(v2.x) * w2, bflo(v3.x) * w3);
      o1.x = cvtpk(bfhi(v0.x) * w0, bfhi(v1.x) * w1); o1.y = cvtpk(bfhi(v2.x) * w2, bfhi(v3.x) * w3);
      o2.x = cvtpk(bflo(v0.y) * w0, bflo(v1.y) * w1); o2.y = cvtpk(bflo(v2.y) * w2, bflo(v3.y) * w3);
      o3.x = cvtpk(bfhi(v0.y) * w0, bfhi(v1.y) * w1); o3.y = cvtpk(bfhi(v2.y) * w2, bfhi(v3.y) * w3);
    } else {
      o0.x = (v0.x & 0xffffu) | (v1.x << 16); o0.y = (v2.x & 0xffffu) | (v3.x << 16);
      o1.x = (v0.x >> 16) | (v1.x & 0xffff0000u); o1.y = (v2.x >> 16) | (v3.x & 0xffff0000u);
      o2.x = (v0.y & 0xffffu) | (v1.y << 16); o2.y = (v2.y & 0xffffu) | (v3.y << 16);
      o3.x = (v0.y >> 16) | (v1.y & 0xffff0000u); o3.y = (v2.y >> 16) | (v3.y & 0xffff0000u);
    }
    char* d = dst + (size_t)(tc * 4) * RS + tt * 8;
    *(u32x2*)d = o0; *(u32x2*)(d + RS) = o1; *(u32x2*)(d + 2 * RS) = o2; *(u32x2*)(d + 3 * RS) = o3;
  }
}
__device__ __forceinline__ void stage_N(const bf16_t* src, int ld, int nrows, int rowbytes, char* dst, int RS) {
  const int cpr = rowbytes >> 4, total = nrows * cpr;
  for (int m = tidx(); m < total; m += NT) {
    const int rr = m / cpr, cc = m - rr * cpr;
    *(u32x4*)(dst + (size_t)rr * RS + cc * 16) = *(const u32x4*)(src + (size_t)rr * ld + cc * 8);
  }
}

__device__ __forceinline__ void phase_prep(const Params& p, char* smem) {
  const int tid = tidx(), lane = tid & 63, w = tid >> 6;
  float* modb = (float*)(WSP(p) + OFF_MOD);
  for (int u = blockIdx.x; u < 144; u += gridDim.x) {
    const int l = u / 72, j0 = (u % 72) * 128;
    float* sl = (float*)smem;
    for (int i = tid; i < 5120; i += NT) {
      const int idx = i >> 10, k = i & 1023;
      const float v = idx < 4 ? PRM(p, c)[idx * 1024 + k] : PRM(p, c_ctx)[k];
      sl[i] = v / (1.f + expf(-v));
    }
    __syncthreads();
    const int jj = tid & 127, kq = tid >> 7;
    float a0 = 0, a1 = 0, a2 = 0, a3 = 0, a4 = 0;
    const float* wp = PRM(p, w_mod) + ((size_t)l * 1024 + kq * 256) * 9216 + j0 + jj;
    const float* sp = sl + kq * 256;
#pragma unroll 8
    for (int k = 0; k < 256; ++k) {
      const float wv = wp[(size_t)k * 9216];
      a0 += sp[k] * wv; a1 += sp[1024 + k] * wv; a2 += sp[2048 + k] * wv; a3 += sp[3072 + k] * wv; a4 += sp[4096 + k] * wv;
    }
    float* red = sl + 5120;
    red[(kq * 5 + 0) * 128 + jj] = a0; red[(kq * 5 + 1) * 128 + jj] = a1; red[(kq * 5 + 2) * 128 + jj] = a2;
    red[(kq * 5 + 3) * 128 + jj] = a3; red[(kq * 5 + 4) * 128 + jj] = a4;
    __syncthreads();
    for (int o = tid; o < 640; o += NT) {
      const int i = o >> 7, j = o & 127;
      const float s = red[(0 * 5 + i) * 128 + j] + red[(1 * 5 + i) * 128 + j] + red[(2 * 5 + i) * 128 + j] + red[(3 * 5 + i) * 128 + j];
      modb[((size_t)l * 5 + i) * 9216 + j0 + j] = s + PRM(p, b_mod)[l * 9216 + j0 + j];
    }
    __syncthreads();
  }
  if (blockIdx.x == 0 && w == 0) {
    float* sc = (float*)(WSP(p) + OFF_SCAL);
    const float mq = wave_max(fabsf(PRM(p, na_q_g)[lane])), mk = wave_max(fabsf(PRM(p, na_k_g)[lane]));
    float mr = 0.f;
    for (int i = lane; i < 8 * 15 * 31; i += 64) mr = fmaxf(mr, fabsf(PRM(p, na_rpb)[i]));
    mr = wave_max(mr);
    const float dq = wave_max(fabsf(PRM(p, diff_q_g)[lane])), dk = wave_max(fabsf(PRM(p, diff_k_g)[lane]));
    const float s1 = wave_sum(PRM(p, diff_lambda)[lane] * PRM(p, diff_lambda)[64 + lane]);
    const float s2 = wave_sum(PRM(p, diff_lambda)[128 + lane] * PRM(p, diff_lambda)[192 + lane]);
    if (lane == 0) {
      sc[0] = (8.f * mq * mk + mr) * LOG2E;
      sc[1] = 8.f * dq * dk * LOG2E;
      sc[2] = expf(s1) - expf(s2) + LAM_INIT;
    }
  }
  float* tile = (float*)smem + w * (64 * 65);
  const int gw = blockIdx.x * 8 + w, nw = gridDim.x * 8;
  constexpr int T_FFN = 12 * 704, T_ABIN = T_FFN + 800, T_ABOUT = T_ABIN + 256, T_CDIN = T_ABOUT + 640, T_CDOUT = T_CDIN + 256,
                T_WA = T_CDOUT + 16, T_WX = T_WA + 16;
  for (int t = gw; t < T_WX; t += nw) {
    const float* src; bf16_t* dst; int K, N, ntn, mode = 0, tl;
    if (t < T_FFN) {
      const int j = t / 704, cidx = j / 3, kind = j - cidx * 3; tl = t - j * 704;
      if (kind == 2) { src = PRM(p, ffn_w2) + (size_t)cidx * DFF * DM; dst = (bf16_t*)(WSP(p) + OFF_W2) + (size_t)cidx * DM * DFF; K = DFF; N = DM; ntn = 16; }
      else { src = (kind == 0 ? PRM(p, ffn_w1) : PRM(p, ffn_w3)) + (size_t)cidx * DM * DFF; dst = (bf16_t*)(WSP(p) + OFF_W13) + (size_t)cidx * 5632 * DM; K = DM; N = DFF; ntn = 44; mode = 1 + kind; }
    } else if (t < T_ABIN) { tl = t - T_FFN; src = PRM(p, ab_w_in); dst = (bf16_t*)(WSP(p) + OFF_WABIN); K = 1024; N = 3088; ntn = 50; }
    else if (t < T_ABOUT) { tl = t - T_ABIN; src = PRM(p, ab_w_out); dst = (bf16_t*)(WSP(p) + OFF_WABOUT); K = 1024; N = 1024; ntn = 16; mode = 3; }
    else if (t < T_CDIN) { tl = t - T_ABOUT; src = PRM(p, cd_w_in); dst = (bf16_t*)(WSP(p) + OFF_WCDIN); K = 1024; N = 2560; ntn = 40; }
    else if (t < T_CDOUT) { tl = t - T_CDIN; src = PRM(p, cd_w_out); dst = (bf16_t*)(WSP(p) + OFF_WCDOUT); K = 1024; N = 1024; ntn = 16; }
    else if (t < T_WA) { tl = t - T_CDOUT; src = PRM(p, lru_wa) + (size_t)tl * 4096; dst = (bf16_t*)(WSP(p) + OFF_WLRU) + (size_t)tl * 4096; K = 64; N = 64; ntn = 1; tl = 0; }
    else { tl = t - T_WA; src = PRM(p, lru_wx) + (size_t)tl * 4096; dst = (bf16_t*)(WSP(p) + OFF_WLRU) + (size_t)(16 + tl) * 4096; K = 64; N = 64; ntn = 1; tl = 0; }
    const int tk = tl / ntn, tn = tl - tk * ntn, k0 = tk * 64, n0 = tn * 64;
#pragma unroll 4
    for (int it = 0; it < 16; ++it) {
      const int idx = it * 64 + lane, kk = idx >> 4, n4 = (idx & 15) * 4;
      f32x4 v = {0.f, 0.f, 0.f, 0.f};
      if (n0 + n4 < N) v = *(const f32x4*)(src + (size_t)(k0 + kk) * N + n0 + n4);
      float* tp = tile + kk * 65 + n4;
      tp[0] = v[0]; tp[1] = v[1]; tp[2] = v[2]; tp[3] = v[3];
    }
    __builtin_amdgcn_wave_barrier();
#pragma unroll 2
    for (int it = 0; it < 8; ++it) {
      const int idx = it * 64 + lane, nn = idx >> 3, kc = idx & 7;
      float e[8];
#pragma unroll
      for (int j = 0; j < 8; ++j) e[j] = tile[(kc * 8 + j) * 65 + nn];
      if (mode == 3 && k0 >= 512) {
#pragma unroll
        for (int j = 0; j < 8; ++j) e[j] *= PRM(p, ssd_norm_g)[k0 - 512 + kc * 8 + j];
      }
      const int n = n0 + nn;
      int rho = n;
      if (mode == 1 || mode == 2) rho = 32 * (n >> 4) + 16 * (mode - 1) + (n & 15);
      u32x4 o = {cvtpk(e[0], e[1]), cvtpk(e[2], e[3]), cvtpk(e[4], e[5]), cvtpk(e[6], e[7])};
      *(u32x4*)(dst + (size_t)rho * K + k0 + kc * 8) = o;
    }
    __builtin_amdgcn_wave_barrier();
  }
}

__device__ __forceinline__ void phase_modnorm(const Params& p, int layer, int k, bool from_input, int nrows) {
  const int lane = tidx() & 63, w = tidx() >> 6;
  const float* g = PRM(p, norm_g) + ((size_t)layer * 3 + k) * DM;
  const float* modb = (const float*)(WSP(p) + OFF_MOD) + (size_t)layer * 5 * 9216;
  bf16_t* H = (bf16_t*)(WSP(p) + OFF_H);
  for (int row = blockIdx.x * 8 + w; row < nrows; row += gridDim.x * 8) {
    const float* xr = from_input ? xinrow(p, row) : xrow(p, row);
    f32x4 v[4];
    float ss = 0.f;
#pragma unroll
    for (int i = 0; i < 4; ++i) {
      v[i] = *(const f32x4*)(xr + i * 256 + lane * 4);
      ss += v[i][0] * v[i][0] + v[i][1] * v[i][1] + v[i][2] * v[i][2] + v[i][3] * v[i][3];
    }
    ss = wave_sum(ss);
    const float rstd = rsqrtf(ss * (1.f / 1024.f) + EPS);
    const float* mrow = modb + (size_t)modidx(row) * 9216 + (3 * k) * 1024;
#pragma unroll
    for (int i = 0; i < 4; ++i) {
      const int col = i * 256 + lane * 4;
      const f32x4 gg = *(const f32x4*)(g + col), sh = *(const f32x4*)(mrow + col), sc = *(const f32x4*)(mrow + 1024 + col);
      float o[4];
#pragma unroll
      for (int j = 0; j < 4; ++j) o[j] = (v[i][j] * rstd * gg[j]) * (1.f + sc[j]) + sh[j];
      u32x2 pk = {cvtpk(o[0], o[1]), cvtpk(o[2], o[3])};
      *(u32x2*)(H + (size_t)row * DM + col) = pk;
    }
  }
}

constexpr int G_STAGE = 55296;
template <class Epi>
__device__ __forceinline__ void gemm_phase(const bf16_t* A, int lda, const bf16_t* Bt, int K, int Mrows, int N, int koff,
                                           const float* ssq, Epi epi, char* smem) {
  const int tid = tidx(), lane = tid & 63, w = tid >> 6, wr = w >> 1, wc = w & 1, r = lane & 15, q = lane >> 4;
  const int nN = N / 128, nunits = (Mrows / 256) * nN, nk = K / 64;
  const int lrow = tid >> 3, lkc = tid & 7;
  for (int unit = blockIdx.x; unit < nunits; unit += gridDim.x) {
    const int pm = unit / nN, pn = unit - pm * nN;
    const int row0 = pm * 256, col0 = pn * 128;
    f32x4 acc[4][4];
#pragma unroll
    for (int mi = 0; mi < 4; ++mi)
#pragma unroll
      for (int ni = 0; ni < 4; ++ni) acc[mi][ni] = (f32x4){0.f, 0.f, 0.f, 0.f};
    const bf16_t* gA = A + (size_t)(row0 + lrow) * lda + lkc * 8;
    const bf16_t* gB = Bt + (size_t)(col0 + lrow) * K + lkc * 8;
    u32x4 ra[4], rb[2];
    {
      const int kt = koff;
#pragma unroll
      for (int i = 0; i < 4; ++i) ra[i] = *(const u32x4*)(gA + (size_t)i * 64 * lda + kt * 64);
#pragma unroll
      for (int i = 0; i < 2; ++i) rb[i] = *(const u32x4*)(gB + (size_t)i * 64 * K + kt * 64);
      char* sa = smem;
#pragma unroll
      for (int i = 0; i < 4; ++i) *(u32x4*)(sa + (lrow + i * 64) * 144 + lkc * 16) = ra[i];
#pragma unroll
      for (int i = 0; i < 2; ++i) *(u32x4*)(sa + 36864 + (lrow + i * 64) * 144 + lkc * 16) = rb[i];
    }
    __syncthreads();
    for (int it = 0; it < nk; ++it) {
      if (it + 1 < nk) {
        int kt = it + 1 + koff; if (kt >= nk) kt -= nk;
#pragma unroll
        for (int i = 0; i < 4; ++i) ra[i] = *(const u32x4*)(gA + (size_t)i * 64 * lda + kt * 64);
#pragma unroll
        for (int i = 0; i < 2; ++i) rb[i] = *(const u32x4*)(gB + (size_t)i * 64 * K + kt * 64);
      }
      const char* sa = smem + (it & 1) * G_STAGE;
      const char* sb = sa + 36864;
#pragma unroll
      for (int ks = 0; ks < 2; ++ks) {
        bf16x8 af[4], bfr[4];
#pragma unroll
        for (int mi = 0; mi < 4; ++mi) af[mi] = ldsfrag16(sa + (wr * 64 + mi * 16 + r) * 144 + ks * 64 + q * 16);
#pragma unroll
        for (int ni = 0; ni < 4; ++ni) bfr[ni] = ldsfrag16(sb + (wc * 64 + ni * 16 + r) * 144 + ks * 64 + q * 16);
#pragma unroll
        for (int mi = 0; mi < 4; ++mi)
#pragma unroll
          for (int ni = 0; ni < 4; ++ni) acc[mi][ni] = mfma16(bfr[ni], af[mi], acc[mi][ni]);
      }
      if (ssq != nullptr && it == 7) {
#pragma unroll
        for (int mi = 0; mi < 4; ++mi) {
          const float* sp = ssq + (size_t)(row0 + wr * 64 + mi * 16 + r) * 16;
          const f32x4 s0 = *(const f32x4*)sp, s1 = *(const f32x4*)(sp + 4), s2 = *(const f32x4*)(sp + 8), s3 = *(const f32x4*)(sp + 12);
          const float tot = (s0[0] + s0[1] + s0[2] + s0[3]) + (s1[0] + s1[1] + s1[2] + s1[3]) + (s2[0] + s2[1] + s2[2] + s2[3]) + (s3[0] + s3[1] + s3[2] + s3[3]);
          const float rs = rsqrtf(tot * (1.f / 512.f) + EPS);
#pragma unroll
          for (int ni = 0; ni < 4; ++ni) acc[mi][ni] *= rs;
        }
      }
      if (it + 1 < nk) {
        char* da = smem + ((it + 1) & 1) * G_STAGE;
#pragma unroll
        for (int i = 0; i < 4; ++i) *(u32x4*)(da + (lrow + i * 64) * 144 + lkc * 16) = ra[i];
#pragma unroll
        for (int i = 0; i < 2; ++i) *(u32x4*)(da + 36864 + (lrow + i * 64) * 144 + lkc * 16) = rb[i];
      }
      __syncthreads();
    }
    epi(acc, row0 + wr * 64, col0 + wc * 64, r, q);
  }
}

struct EpiUp {
  bf16_t* G;
  __device__ __forceinline__ void operator()(f32x4 (&acc)[4][4], int rowb, int colb, int r, int q) const {
#pragma unroll
    for (int mi = 0; mi < 4; ++mi) {
      const int row = rowb + mi * 16 + r;
#pragma unroll
      for (int pr = 0; pr < 2; ++pr) {
        const f32x4 g = acc[mi][2 * pr], u = acc[mi][2 * pr + 1];
        const int col = (colb >> 1) + pr * 16 + 4 * q;
        u32x2 o = {cvtpk(siluf(g[0]) * u[0], siluf(g[1]) * u[1]), cvtpk(siluf(g[2]) * u[2], siluf(g[3]) * u[3])};
        *(u32x2*)(G + (size_t)row * DFF + col) = o;
      }
    }
  }
};
struct EpiRes {
  Params p; const float* modl; int gate; float scale; bool from_input;
  __device__ __forceinline__ void operator()(f32x4 (&acc)[4][4], int rowb, int colb, int r, int q) const {
#pragma unroll
    for (int mi = 0; mi < 4; ++mi) {
      const int row = rowb + mi * 16 + r;
      const float* src = from_input ? xinrow(p, row) : xrow(p, row);
      float* dst = xrow(p, row);
      const float* mrow = modl + (size_t)modidx(row) * 9216 + gate * 1024;
#pragma unroll
      for (int ni = 0; ni < 4; ++ni) {
        const int col = colb + ni * 16 + 4 * q;
        const f32x4 s = *(const f32x4*)(src + col), m = *(const f32x4*)(mrow + col);
        f32x4 o;
#pragma unroll
        for (int j = 0; j < 4; ++j) o[j] = s[j] + scale * m[j] * acc[mi][ni][j];
        *(f32x4*)(dst + col) = o;
      }
    }
  }
};
struct EpiInAB {
  bf16_t* U; float* DT; const float* dtb;
  __device__ __forceinline__ void operator()(f32x4 (&acc)[4][4], int rowb, int colb, int r, int q) const {
#pragma unroll
    for (int mi = 0; mi < 4; ++mi) {
      const int row = rowb + mi * 16 + r;
#pragma unroll
      for (int ni = 0; ni < 4; ++ni) {
        const int col = colb + ni * 16 + 4 * q;
        if (col < 3072) {
          u32x2 o = {cvtpk(acc[mi][ni][0], acc[mi][ni][1]), cvtpk(acc[mi][ni][2], acc[mi][ni][3])};
          *(u32x2*)(U + (size_t)row * 3072 + col) = o;
        } else if (col < 3088) {
          f32x4 o;
#pragma unroll
          for (int j = 0; j < 4; ++j) o[j] = softplusf(acc[mi][ni][j] + dtb[col - 3072 + j]);
          *(f32x4*)(DT + (size_t)row * 16 + col - 3072) = o;
        }
      }
    }
  }
};
struct EpiBf {
  bf16_t* U; int ld;
  __device__ __forceinline__ void operator()(f32x4 (&acc)[4][4], int rowb, int colb, int r, int q) const {
#pragma unroll
    for (int mi = 0; mi < 4; ++mi) {
      const int row = rowb + mi * 16 + r;
#pragma unroll
      for (int ni = 0; ni < 4; ++ni) {
        const int col = colb + ni * 16 + 4 * q;
        u32x2 o = {cvtpk(acc[mi][ni][0], acc[mi][ni][1]), cvtpk(acc[mi][ni][2], acc[mi][ni][3])};
        *(u32x2*)(U + (size_t)row * ld + col) = o;
      }
    }
  }
};

__device__ __forceinline__ void phase_mixprep(const Params& p, int layer) {
  bf16_t* U = (bf16_t*)(WSP(p) + OFF_BIG);
  const int ld = layer == 0 ? 3072 : 2560;
  const int qcol0 = layer == 0 ? 0 : 1024;
  const float* qg = layer == 0 ? PRM(p, na_q_g) : PRM(p, diff_q_g);
  const float* kg = layer == 0 ? PRM(p, na_k_g) : PRM(p, diff_k_g);
  const int gtid = blockIdx.x * NT + tidx(), gsz = gridDim.x * NT;
  for (int it = gtid; it < TT * 128; it += gsz) {
    const int row = it >> 7, e = it & 127, grp = e >> 3, sub = e & 7;
    bf16_t* ptr = U + (size_t)row * ld + qcol0 + grp * 64 + sub * 8;
    const u32x4 v = *(const u32x4*)ptr;
    float f[8] = {bflo(v.x), bfhi(v.x), bflo(v.y), bfhi(v.y), bflo(v.z), bfhi(v.z), bflo(v.w), bfhi(v.w)};
    float ss = 0.f;
#pragma unroll
    for (int j = 0; j < 8; ++j) ss += f[j] * f[j];
    ss += __shfl_xor(ss, 1); ss += __shfl_xor(ss, 2); ss += __shfl_xor(ss, 4);
    const float rstd = rsqrtf(ss * (1.f / 64.f) + EPS);
    const bool isq = grp < 8;
    const float* gp = (isq ? qg : kg) + sub * 8;
#pragma unroll
    for (int j = 0; j < 8; ++j) f[j] = f[j] * rstd * gp[j];
    if (layer == 1 && row < TL) {
      const int t = row & 8191, gr = t >> 6, gc = t & 63;
#pragma unroll
      for (int j = 0; j < 4; ++j) {
        const int i = sub * 4 + j;
        const float pos = i < 16 ? (float)gr : (float)gc;
        const float inv = exp2f(-(float)(i & 15) * (13.287712379549449f / 16.f));
        float sn, cs;
        sincosf(pos * inv, &sn, &cs);
        const float x1 = f[2 * j], x2 = f[2 * j + 1];
        f[2 * j] = x1 * cs - x2 * sn; f[2 * j + 1] = x1 * sn + x2 * cs;
      }
    }
    if (isq) {
#pragma unroll
      for (int j = 0; j < 8; ++j) f[j] *= 0.125f * LOG2E;
    }
    u32x4 o = {cvtpk(f[0], f[1]), cvtpk(f[2], f[3]), cvtpk(f[4], f[5]), cvtpk(f[6], f[7])};
    *(u32x4*)ptr = o;
  }
  if (layer == 0) {
    bf16_t* XBC = (bf16_t*)(WSP(p) + OFF_XBC);
    for (int it = gtid; it < TT * 128; it += gsz) {
      const int row = it >> 7, c0 = (it & 127) * 8;
      int t, len;
      if (row < TL) { t = row & 8191; len = 8192; } else { t = (row - TL) & 255; len = 256; }
      float a[8];
#pragma unroll
      for (int j = 0; j < 8; ++j) a[j] = PRM(p, ssd_conv_b)[c0 + j];
#pragma unroll
      for (int k = 0; k < 4; ++k) {
        const int tt = t + k - 2;
        if (tt >= 0 && tt < len) {
          const u32x4 v = *(const u32x4*)(U + (size_t)(row + k - 2) * 3072 + 2048 + c0);
          const float* wk = PRM(p, ssd_conv_w) + k * 1024 + c0;
          a[0] += wk[0] * bflo(v.x); a[1] += wk[1] * bfhi(v.x); a[2] += wk[2] * bflo(v.y); a[3] += wk[3] * bfhi(v.y);
          a[4] += wk[4] * bflo(v.z); a[5] += wk[5] * bfhi(v.z); a[6] += wk[6] * bflo(v.w); a[7] += wk[7] * bfhi(v.w);
        }
      }
#pragma unroll
      for (int j = 0; j < 8; ++j) a[j] = siluf(a[j]);
      u32x4 o = {cvtpk(a[0], a[1]), cvtpk(a[2], a[3]), cvtpk(a[4], a[5]), cvtpk(a[6], a[7])};
      *(u32x4*)(XBC + (size_t)row * 1024 + c0) = o;
    }
  }
}

__device__ __forceinline__ void na_unit(const Params& p, int b, int qtok0, int hq, int grow, char* smem) {
  const int tid = tidx(), lane = tid & 63, w = tid >> 6, hl = w >> 1, half = w & 1, l31 = lane & 31, h = lane >> 5;
  const bf16_t* U = (const bf16_t*)(WSP(p) + OFF_BIG);
  bf16_t* H = (bf16_t*)(WSP(p) + OFF_H);
  char* Ks = smem;
  char* Vt = smem + 36864;
  float* rp = (float*)(smem + 36864 + 34816);
  const float Mb = ((const float*)(WSP(p) + OFF_SCAL))[0];
  const int head = hq * 4 + hl;
  const int qtok = qtok0 + half * 32 + l31;
  bf16x8 qf[4];
#pragma unroll
  for (int s = 0; s < 4; ++s) qf[s] = *(const bf16x8*)(U + (size_t)qtok * 3072 + head * 64 + s * 16 + h * 8);
  f32x16 o0, o1;
#pragma unroll
  for (int i = 0; i < 16; ++i) { o0[i] = 0.f; o1[i] = 0.f; }
  float lsum = 0.f;
  const bool lat = grow >= 0;
  int r0 = 0;
  if (lat) {
    r0 = min(max(grow - 4, 0), 120);
    for (int i = tid; i < 4 * 465; i += NT) rp[i] = PRM(p, na_rpb)[(size_t)hq * 4 * 465 + i] * LOG2E;
  }
  const int cq = half * 32 + l31;
  for (int kt = lat ? 0 : 8; kt < 12; ++kt) {
    const int ktok0 = kt < 8 ? b * 8192 + (r0 + kt) * 64 : TL + b * 256 + (kt - 8) * 64;
    __syncthreads();
#pragma unroll
    for (int i = 0; i < 4; ++i) {
      const int c = tid + i * NT, key = c >> 5, hh = (c >> 3) & 3, kc = c & 7;
      *(u32x4*)(Ks + hh * 9216 + key * 144 + kc * 16) = *(const u32x4*)(U + (size_t)(ktok0 + key) * 3072 + 512 + hq * 256 + hh * 64 + kc * 8);
    }
    stage_T<false>(U + (size_t)ktok0 * 3072 + 1024 + hq * 256, 3072, 64, 256, Vt, 136, nullptr);
    __syncthreads();
    const int dr = r0 + kt - grow + 7;
    int cql = cq;
    asm volatile("" : "+v"(cql));
    const int qc0l = min(max(cql - 8, 0), 48);
#pragma unroll
    for (int kb = 0; kb < 2; ++kb) {
      f32x16 s;
#pragma unroll
      for (int i = 0; i < 16; ++i) s[i] = 0.f;
#pragma unroll
      for (int sp = 0; sp < 4; ++sp) s = mfma32(ldsfrag16(Ks + hl * 9216 + (kb * 32 + l31) * 144 + sp * 32 + h * 16), qf[sp], s);
      float pv[16];
#pragma unroll
      for (int i = 0; i < 16; ++i) {
        float v = s[i] - Mb;
        bool valid = true;
        if (kt < 8) {
          const int kc = kb * 32 + (i & 3) + 8 * (i >> 2) + 4 * h;
          valid = (kc >= qc0l) && (kc < qc0l + 16);
          const int bi = valid ? (dr * 31 + kc - cql + 15) : 0;
          v += rp[hl * 465 + bi];
        }
        const float e = __builtin_amdgcn_exp2f(v);
        pv[i] = valid ? e : 0.f;
        lsum += pv[i];
      }
#pragma unroll
      for (int ss = 0; ss < 2; ++ss) {
        u32x4 pk = {cvtpk(pv[8 * ss], pv[8 * ss + 1]), cvtpk(pv[8 * ss + 2], pv[8 * ss + 3]), cvtpk(pv[8 * ss + 4], pv[8 * ss + 5]), cvtpk(pv[8 * ss + 6], pv[8 * ss + 7])};
        const bf16x8 pf = __builtin_bit_cast(bf16x8, pk);
        const char* vb = Vt + (size_t)(hl * 64 + l31) * 136 + (kb * 32 + ss * 16 + 4 * h) * 2;
        o0 = mfma32(ldsfrag8x2(vb, vb + 16), pf, o0);
        o1 = mfma32(ldsfrag8x2(vb + 32 * 136, vb + 32 * 136 + 16), pf, o1);
      }
    }
  }
  lsum += __shfl_xor(lsum, 32);
  float inv = 1.f / lsum;
#ifdef NA_ZERO
  inv = 0.f * (lsum > 0.f ? 1.f : 0.f); for (int i = 0; i < 16; ++i) { o0[i] = 1.f; o1[i] = 1.f; }
#endif
  bf16_t* hp = H + (size_t)qtok * DM + head * 64;
#pragma unroll
  for (int g = 0; g < 4; ++g) {
    u32x2 a = {cvtpk(o0[4 * g] * inv, o0[4 * g + 1] * inv), cvtpk(o0[4 * g + 2] * inv, o0[4 * g + 3] * inv)};
    u32x2 c = {cvtpk(o1[4 * g] * inv, o1[4 * g + 1] * inv), cvtpk(o1[4 * g + 2] * inv, o1[4 * g + 3] * inv)};
    *(u32x2*)(hp + 8 * g + 4 * h) = a;
    *(u32x2*)(hp + 32 + 8 * g + 4 * h) = c;
  }
  __syncthreads();
}

__device__ __forceinline__ void wave_cumsum2(float v0, float v1, float& c0, float& c1, float& tot, int lane) {
  float s = v0 + v1;
#pragma unroll
  for (int o = 1; o < 64; o <<= 1) { const float t = __shfl_up(s, o); if (lane >= o) s += t; }
  c1 = s; c0 = s - v1; tot = __shfl(s, 63);
}
__device__ __forceinline__ void ssdA_unit(const Params& p, int b, int cc, int head, char* smem) {
  const int tid = tidx(), lane = tid & 63, w = tid >> 6, l31 = lane & 31, h = lane >> 5;
  const int tok0 = chunk_tok0(b, cc), g = head >> 2;
  const bf16_t* XBC = (const bf16_t*)(WSP(p) + OFF_XBC);
  const float* DT = (const float*)(WSP(p) + OFF_DT);
  char* BT = smem;
  char* XWT = smem + 34816;
  float* wl = (float*)(smem + 69632);
  if (w < 2) {
    const int dir = w;
    const float d0 = DT[(size_t)(tok0 + 2 * lane) * 16 + dir * 8 + head], d1 = DT[(size_t)(tok0 + 2 * lane + 1) * 16 + dir * 8 + head];
    const float Aa = -expf(PRM(p, ssd_a_log)[dir * 8 + head]);
    const float v0 = d0 * Aa, v1 = d1 * Aa;
    float c0, c1, tot;
    wave_cumsum2(v0, v1, c0, c1, tot, lane);
    if (dir == 0) { wl[2 * lane] = expf(tot - c0) * d0; wl[2 * lane + 1] = expf(tot - c1) * d1; }
    else { wl[128 + 2 * lane] = expf(c0 - v0) * d0; wl[128 + 2 * lane + 1] = expf(c1 - v1) * d1; }
    if (lane == 0) ((float*)(WSP(p) + OFF_DEC))[((b * 2 + dir) * 8 + head) * 66 + cc] = expf(tot);
  }
  __syncthreads();
  stage_T<false>(XBC + (size_t)tok0 * 1024 + 512 + g * 128, 1024, 128, 128, BT, 272, nullptr);
  stage_T<true>(XBC + (size_t)tok0 * 1024 + head * 64, 1024, 128, 64, XWT, 272, wl);
  stage_T<true>(XBC + (size_t)tok0 * 1024 + head * 64, 1024, 128, 64, XWT + 17408, 272, wl + 128);
  __syncthreads();
  {
    const int dir = w >> 2, nb = w & 3;
    f32x16 a0, a1;
#pragma unroll
    for (int i = 0; i < 16; ++i) { a0[i] = 0.f; a1[i] = 0.f; }
    const char* xb = XWT + dir * 17408;
#pragma unroll
    for (int ks = 0; ks < 8; ++ks) {
      const bf16x8 bt = ldsfrag16(BT + (nb * 32 + l31) * 272 + ks * 32 + h * 16);
      a0 = mfma32(bt, ldsfrag16(xb + l31 * 272 + ks * 32 + h * 16), a0);
      a1 = mfma32(bt, ldsfrag16(xb + (32 + l31) * 272 + ks * 32 + h * 16), a1);
    }
    bf16_t* st = (bf16_t*)(WSP(p) + OFF_ST) + ((size_t)(((b * 2 + dir) * 8 + head) * 66 + cc)) * 8192;
#pragma unroll
    for (int gg = 0; gg < 4; ++gg) {
      const int n = nb * 32 + 8 * gg + 4 * h;
      u32x2 x0 = {cvtpk(a0[4 * gg], a0[4 * gg + 1]), cvtpk(a0[4 * gg + 2], a0[4 * gg + 3])};
      u32x2 x1 = {cvtpk(a1[4 * gg], a1[4 * gg + 1]), cvtpk(a1[4 * gg + 2], a1[4 * gg + 3])};
      *(u32x2*)(st + (size_t)l31 * 128 + n) = x0;
      *(u32x2*)(st + (size_t)(32 + l31) * 128 + n) = x1;
    }
  }
  __syncthreads();
}
__device__ __forceinline__ int scan_order(int dir, int s) { return dir == 0 ? s : (s == 0 ? 1 : (s == 1 ? 0 : 67 - s)); }
__device__ __forceinline__ void phase_ssdB(const Params& p) {
  const int gtid = blockIdx.x * NT + tidx(), gsz = gridDim.x * NT;
  bf16_t* ST = (bf16_t*)(WSP(p) + OFF_ST);
  const float* DEC = (const float*)(WSP(p) + OFF_DEC);
  for (int item = gtid; item < 64 * 2048; item += gsz) {
    const int combo = item >> 11, e = (item & 2047) * 4;
    const int dir = (combo >> 3) & 1;
    bf16_t* base = ST + (size_t)combo * 66 * 8192 + e;
    const float* dec = DEC + combo * 66;
    float h0 = 0.f, h1 = 0.f, h2 = 0.f, h3 = 0.f;
    for (int s = 0; s < 66; ++s) {
      const int cc = scan_order(dir, s);
      bf16_t* ptr = base + (size_t)cc * 8192;
      const u32x2 v = *(const u32x2*)ptr;
      const float d = dec[cc];
      u32x2 o = {cvtpk(h0, h1), cvtpk(h2, h3)};
      *(u32x2*)ptr = o;
      h0 = h0 * d + bflo(v.x); h1 = h1 * d + bfhi(v.x); h2 = h2 * d + bflo(v.y); h3 = h3 * d + bfhi(v.y);
    }
  }
}
__device__ __forceinline__ void ssdC_unit(const Params& p, int b, int cc, int head, char* smem) {
  const int tid = tidx(), lane = tid & 63, w = tid >> 6, l31 = lane & 31, h = lane >> 5;
  const int tok0 = chunk_tok0(b, cc), g = head >> 2;
  const bf16_t* XBC = (const bf16_t*)(WSP(p) + OFF_XBC);
  const bf16_t* U = (const bf16_t*)(WSP(p) + OFF_BIG);
  const float* DT = (const float*)(WSP(p) + OFF_DT);
  bf16_t* H = (bf16_t*)(WSP(p) + OFF_H);
  char* Cn = smem;
  char* Bn = smem + 34816;
  char* XT = smem + 69632;
  char* Hf = smem + 87040;
  char* Hb = smem + 104448;
  float* vec = (float*)(smem + 121856);
  if (w < 2) {
    const int dir = w;
    const float d0 = DT[(size_t)(tok0 + 2 * lane) * 16 + dir * 8 + head], d1 = DT[(size_t)(tok0 + 2 * lane + 1) * 16 + dir * 8 + head];
    const float Aa = -expf(PRM(p, ssd_a_log)[dir * 8 + head]);
    const float v0 = d0 * Aa, v1 = d1 * Aa;
    float c0, c1, tot;
    wave_cumsum2(v0, v1, c0, c1, tot, lane);
    if (dir == 0) {
      vec[2 * lane] = c0; vec[2 * lane + 1] = c1; vec[256 + 2 * lane] = d0; vec[256 + 2 * lane + 1] = d1;
      vec[512 + 2 * lane] = expf(c0); vec[512 + 2 * lane + 1] = expf(c1);
    } else {
      vec[128 + 2 * lane] = c0 - v0; vec[128 + 2 * lane + 1] = c1 - v1; vec[384 + 2 * lane] = d0; vec[384 + 2 * lane + 1] = d1;
      vec[640 + 2 * lane] = expf(tot - (c0 - v0)); vec[640 + 2 * lane + 1] = expf(tot - (c1 - v1));
    }
  }
  stage_N(XBC + (size_t)tok0 * 1024 + 768 + g * 128, 1024, 128, 256, Cn, 272);
  stage_N(XBC + (size_t)tok0 * 1024 + 512 + g * 128, 1024, 128, 256, Bn, 272);
  stage_T<false>(XBC + (size_t)tok0 * 1024 + head * 64, 1024, 128, 64, XT, 272, nullptr);
  const bf16_t* ST = (const bf16_t*)(WSP(p) + OFF_ST);
  stage_N(ST + ((size_t)(((b * 2 + 0) * 8 + head) * 66 + cc)) * 8192, 128, 64, 256, Hf, 272);
  stage_N(ST + ((size_t)(((b * 2 + 1) * 8 + head) * 66 + cc)) * 8192, 128, 64, 256, Hb, 272);
  __syncthreads();
  const float* csf = vec; const float* exb = vec + 128; const float* dtf = vec + 256; const float* dtb = vec + 384;
  const float* ef = vec + 512; const float* eb = vec + 640;
  {
    const int ib = w & 3, jb0 = (w >> 2) * 2;
    f32x16 c0, c1;
#pragma unroll
    for (int i = 0; i < 16; ++i) { c0[i] = 0.f; c1[i] = 0.f; }
#pragma unroll
    for (int ks = 0; ks < 8; ++ks) {
      const bf16x8 cf = ldsfrag16(Cn + (ib * 32 + l31) * 272 + ks * 32 + h * 16);
      c0 = mfma32(ldsfrag16(Bn + (jb0 * 32 + l31) * 272 + ks * 32 + h * 16), cf, c0);
      c1 = mfma32(ldsfrag16(Bn + ((jb0 + 1) * 32 + l31) * 272 + ks * 32 + h * 16), cf, c1);
    }
    __syncthreads();
    const int i = ib * 32 + l31;
    const float csi = csf[i], exi = exb[i];
#pragma unroll
    for (int jj = 0; jj < 2; ++jj) {
#pragma unroll
      for (int gg = 0; gg < 4; ++gg) {
        const int j0 = (jb0 + jj) * 32 + 8 * gg + 4 * h;
        float m[4];
#pragma unroll
        for (int x = 0; x < 4; ++x) {
          const int j = j0 + x;
          const float cb = jj == 0 ? c0[4 * gg + x] : c1[4 * gg + x];
          float fv = 0.f;
          if (j <= i) fv += __expf(csi - csf[j]) * dtf[j];
          if (j >= i) fv += __expf(exb[j] - exi) * dtb[j];
          m[x] = cb * fv;
        }
        u32x2 o = {cvtpk(m[0], m[1]), cvtpk(m[2], m[3])};
        *(u32x2*)(Bn + i * 272 + j0 * 2) = o;
      }
    }
  }
  __syncthreads();
  {
    const int pb = w >> 2, ib = w & 3;
    f32x16 yd, yf, yb;
#pragma unroll
    for (int i = 0; i < 16; ++i) { yd[i] = 0.f; yf[i] = 0.f; yb[i] = 0.f; }
#pragma unroll
    for (int ks = 0; ks < 8; ++ks) {
      yd = mfma32(ldsfrag16(XT + (pb * 32 + l31) * 272 + ks * 32 + h * 16), ldsfrag16(Bn + (ib * 32 + l31) * 272 + ks * 32 + h * 16), yd);
      const bf16x8 cf = ldsfrag16(Cn + (ib * 32 + l31) * 272 + ks * 32 + h * 16);
      yf = mfma32(ldsfrag16(Hf + (pb * 32 + l31) * 272 + ks * 32 + h * 16), cf, yf);
      yb = mfma32(ldsfrag16(Hb + (pb * 32 + l31) * 272 + ks * 32 + h * 16), cf, yb);
    }
    const int i = ib * 32 + l31, tok = tok0 + i;
    const float e_f = ef[i], e_b = eb[i], Dk = PRM(p, ssd_d)[head];
    float ssq = 0.f;
#pragma unroll
    for (int gg = 0; gg < 4; ++gg) {
      const int p0 = pb * 32 + 8 * gg + 4 * h;
      const u32x2 xv = *(const u32x2*)(XBC + (size_t)tok * 1024 + head * 64 + p0);
      const u32x2 zv = *(const u32x2*)(U + (size_t)tok * 3072 + 1536 + head * 64 + p0);
      const float xs[4] = {bflo(xv.x), bfhi(xv.x), bflo(xv.y), bfhi(xv.y)};
      const float zs[4] = {bflo(zv.x), bfhi(zv.x), bflo(zv.y), bfhi(zv.y)};
      float gv[4];
#pragma unroll
      for (int x = 0; x < 4; ++x) {
        const float y = yd[4 * gg + x] + e_f * yf[4 * gg + x] + e_b * yb[4 * gg + x] + Dk * xs[x];
        gv[x] = y * siluf(zs[x]);
        ssq += gv[x] * gv[x];
      }
      u32x2 o = {cvtpk(gv[0], gv[1]), cvtpk(gv[2], gv[3])};
      *(u32x2*)(H + (size_t)tok * DM + 512 + head * 64 + p0) = o;
    }
    ssq += __shfl_xor(ssq, 32);
    if (h == 0) ((float*)(WSP(p) + OFF_SSQ))[(size_t)tok * 16 + head * 2 + pb] = ssq;
  }
  __syncthreads();
}

__device__ __forceinline__ void lru_unit(const Params& p, int b, int cc, int nb, int mode, char* smem) {
  const int tid = tidx(), lane = tid & 63, w = tid >> 6, l31 = lane & 31, h = lane >> 5;
  const int tok0 = chunk_tok0(b, cc);
  const bf16_t* U = (const bf16_t*)(WSP(p) + OFF_BIG);
  float* xf = (float*)smem;
  float* aL = (float*)(smem + 34816);
  float* bL = (float*)(smem + 67584);
  float* hs = (float*)(smem + 100352);
  float* segA = (float*)(smem + 133120);
  float* segH = segA + 512;
  float* segS = segH + 512;
  {
    const int t = tid >> 2, c0 = (tid & 3) * 16;
    int tseq, len;
    if (cc < 2) { tseq = cc * 128 + t; len = 256; } else { tseq = (cc - 2) * 128 + t; len = 8192; }
    float a[16];
#pragma unroll
    for (int j = 0; j < 16; ++j) a[j] = PRM(p, lru_conv_b)[nb * 64 + c0 + j];
#pragma unroll
    for (int k = 0; k < 4; ++k) {
      const int ts = tseq + k - 2;
      if (ts >= 0 && ts < len) {
        const bf16_t* sp = U + (size_t)(tok0 + t + k - 2) * 2560 + 512 + nb * 64 + c0;
        const u32x4 v0 = *(const u32x4*)sp, v1 = *(const u32x4*)(sp + 8);
        const float* wk = PRM(p, lru_conv_w) + k * 512 + nb * 64 + c0;
        a[0] += wk[0] * bflo(v0.x); a[1] += wk[1] * bfhi(v0.x); a[2] += wk[2] * bflo(v0.y); a[3] += wk[3] * bfhi(v0.y);
        a[4] += wk[4] * bflo(v0.z); a[5] += wk[5] * bfhi(v0.z); a[6] += wk[6] * bflo(v0.w); a[7] += wk[7] * bfhi(v0.w);
        a[8] += wk[8] * bflo(v1.x); a[9] += wk[9] * bfhi(v1.x); a[10] += wk[10] * bflo(v1.y); a[11] += wk[11] * bfhi(v1.y);
        a[12] += wk[12] * bflo(v1.z); a[13] += wk[13] * bfhi(v1.z); a[14] += wk[14] * bflo(v1.w); a[15] += wk[15] * bfhi(v1.w);
      }
    }
#pragma unroll
    for (int j = 0; j < 16; ++j) xf[t * 68 + c0 + j] = a[j];
  }
  __syncthreads();
  const bf16_t* WL = (const bf16_t*)(WSP(p) + OFF_WLRU);
  for (int dir = 0; dir < 2; ++dir) {
    {
      const int tb = w >> 1, eb = w & 1;
      f32x16 ra, ia;
#pragma unroll
      for (int i = 0; i < 16; ++i) { ra[i] = 0.f; ia[i] = 0.f; }
      const int e = eb * 32 + l31;
      const bf16_t* wa = WL + ((size_t)((0 * 2 + dir) * 8 + nb)) * 4096 + e * 64;
      const bf16_t* wx = WL + ((size_t)((1 * 2 + dir) * 8 + nb)) * 4096 + e * 64;
#pragma unroll
      for (int s = 0; s < 4; ++s) {
        const float* xp = xf + (tb * 32 + l31) * 68 + s * 16 + h * 8;
        const f32x4 x0 = *(const f32x4*)xp, x1 = *(const f32x4*)(xp + 4);
        u32x4 pk = {cvtpk(x0[0], x0[1]), cvtpk(x0[2], x0[3]), cvtpk(x1[0], x1[1]), cvtpk(x1[2], x1[3])};
        const bf16x8 xa = __builtin_bit_cast(bf16x8, pk);
        ra = mfma32(xa, *(const bf16x8*)(wa + s * 16 + h * 8), ra);
        ia = mfma32(xa, *(const bf16x8*)(wx + s * 16 + h * 8), ia);
      }
      const int ch = nb * 64 + e;
      const float ba = PRM(p, lru_ba)[dir * 512 + ch], bx = PRM(p, lru_bx)[dir * 512 + ch];
      const float sp = softplusf(-PRM(p, lru_lambda)[dir * 512 + ch]);
#pragma unroll
      for (int i = 0; i < 16; ++i) {
        const int t = tb * 32 + (i & 3) + 8 * (i >> 2) + 4 * h;
        const float rg = sigmf(ra[i] + ba), ig = sigmf(ia[i] + bx);
        const float la = -8.f * rg * sp;
        const float av = __expf(la);
        const float bv = sqrtf(fmaxf(-expm1f(2.f * la), 0.f)) * ig * xf[t * 68 + e];
        aL[t * 64 + e] = av; bL[t * 64 + e] = bv;
      }
    }
    __syncthreads();
    const int c = tid & 63, seg = tid >> 6;
    {
      float As = 1.f, Hs = 0.f;
#pragma unroll
      for (int k = 0; k < 16; ++k) {
        const int t = dir == 0 ? seg * 16 + k : 127 - (seg * 16 + k);
        const float av = aL[t * 64 + c];
        Hs = av * Hs + bL[t * 64 + c]; As *= av;
      }
      segA[seg * 64 + c] = As; segH[seg * 64 + c] = Hs;
    }
    __syncthreads();
    const size_t cidx = ((size_t)((b * 2 + dir) * 66 + cc)) * 512 + nb * 64 + c;
    if (mode == 0) {
      if (tid < 64) {
        float At = 1.f, Ht = 0.f;
#pragma unroll
        for (int s = 0; s < 8; ++s) { Ht = segA[s * 64 + c] * Ht + segH[s * 64 + c]; At *= segA[s * 64 + c]; }
        ((float*)(WSP(p) + OFF_LCA))[cidx] = At; ((float*)(WSP(p) + OFF_LCH))[cidx] = Ht;
      }
    } else {
      if (tid < 64) {
        float hcur = ((const float*)(WSP(p) + OFF_LHIN))[cidx];
#pragma unroll
        for (int s = 0; s < 8; ++s) { segS[s * 64 + c] = hcur; hcur = segA[s * 64 + c] * hcur + segH[s * 64 + c]; }
      }
      __syncthreads();
      float hcur = segS[seg * 64 + c];
#pragma unroll
      for (int k = 0; k < 16; ++k) {
        const int t = dir == 0 ? seg * 16 + k : 127 - (seg * 16 + k);
        hcur = aL[t * 64 + c] * hcur + bL[t * 64 + c];
        if (dir == 0) hs[t * 64 + c] = hcur; else hs[t * 64 + c] += hcur;
      }
    }
    __syncthreads();
  }
  if (mode == 1) {
    const int t = tid >> 2, c0 = (tid & 3) * 16;
    const bf16_t* gp = U + (size_t)(tok0 + t) * 2560 + nb * 64 + c0;
    const u32x4 g0 = *(const u32x4*)gp, g1 = *(const u32x4*)(gp + 8);
    const float gt[16] = {bflo(g0.x), bfhi(g0.x), bflo(g0.y), bfhi(g0.y), bflo(g0.z), bfhi(g0.z), bflo(g0.w), bfhi(g0.w),
                          bflo(g1.x), bfhi(g1.x), bflo(g1.y), bfhi(g1.y), bflo(g1.z), bfhi(g1.z), bflo(g1.w), bfhi(g1.w)};
    float o[16];
#pragma unroll
    for (int j = 0; j < 16; ++j) o[j] = gelu_tanh(gt[j]) * hs[t * 64 + c0 + j];
    bf16_t* hp = (bf16_t*)(WSP(p) + OFF_H) + (size_t)(tok0 + t) * DM + nb * 64 + c0;
    u32x4 o0 = {cvtpk(o[0], o[1]), cvtpk(o[2], o[3]), cvtpk(o[4], o[5]), cvtpk(o[6], o[7])};
    u32x4 o1 = {cvtpk(o[8], o[9]), cvtpk(o[10], o[11]), cvtpk(o[12], o[13]), cvtpk(o[14], o[15])};
    *(u32x4*)hp = o0; *(u32x4*)(hp + 8) = o1;
    __syncthreads();
  }
}
__device__ __forceinline__ void phase_lruY(const Params& p) {
  const int gtid = blockIdx.x * NT + tidx();
  if (gtid < 4096) {
    const int ch = gtid & 511, bd = gtid >> 9, dir = bd & 1;
    const float* CA = (const float*)(WSP(p) + OFF_LCA) + (size_t)bd * 66 * 512 + ch;
    const float* CH = (const float*)(WSP(p) + OFF_LCH) + (size_t)bd * 66 * 512 + ch;
    float* HIN = (float*)(WSP(p) + OFF_LHIN) + (size_t)bd * 66 * 512 + ch;
    float hcur = 0.f;
    for (int s = 0; s < 66; ++s) {
      const int cc = scan_order(dir, s);
      HIN[cc * 512] = hcur;
      hcur = CA[cc * 512] * hcur + CH[cc * 512];
    }
  }
}

__device__ __forceinline__ void diff_unit(const Params& p, int b, int head, int qb, char* smem) {
  const int tid = tidx(), lane = tid & 63, w = tid >> 6, l31 = lane & 31, h = lane >> 5, grp = w >> 1, t = w & 1;
  const bf16_t* U = (const bf16_t*)(WSP(p) + OFF_BIG);
  const float* sc = (const float*)(WSP(p) + OFF_SCAL);
  const float Mb = sc[1], lam = sc[2];
  const int qtok = b * 8192 + qb * 128 + grp * 32 + l31;
  char* Qs = smem;
  char* stg = smem + 34816;
  stage_N(U + (size_t)(b * 8192 + qb * 128) * 2560 + 1024 + head * 128, 2560, 128, 256, Qs, 272);
  const char* qrow = Qs + (grp * 32 + l31) * 272 + t * 128 + h * 16;
  f32x16 o[4];
#pragma unroll
  for (int d = 0; d < 4; ++d)
#pragma unroll
    for (int i = 0; i < 16; ++i) o[d][i] = 0.f;
  float lsum = 0.f;
  constexpr int DSTAGE = 34816;
  const int krow = tid >> 4, kcc = tid & 15;
  const int vtc = tid & 31, vtt = tid >> 5;
  u32x4 rk0, rk1; u32x2 rv0, rv1, rv2, rv3;
  auto gload = [&](int kt) {
    const int ktk = kt < 4 ? TL + b * 256 + kt * 64 : b * 8192 + (kt - 4) * 64;
    const bf16_t* base = U + (size_t)ktk * 2560;
    rk0 = *(const u32x4*)(base + (size_t)krow * 2560 + 1536 + head * 128 + kcc * 8);
    rk1 = *(const u32x4*)(base + (size_t)(krow + 32) * 2560 + 1536 + head * 128 + kcc * 8);
    const bf16_t* vs = base + (size_t)(vtt * 4) * 2560 + 2048 + head * 128 + vtc * 4;
    rv0 = *(const u32x2*)vs; rv1 = *(const u32x2*)(vs + 2560); rv2 = *(const u32x2*)(vs + 2 * 2560); rv3 = *(const u32x2*)(vs + 3 * 2560);
  };
  auto lstore = [&](int buf) {
    char* Ks = stg + buf * DSTAGE; char* Vt = Ks + 17408;
    *(u32x4*)(Ks + krow * 272 + kcc * 16) = rk0;
    *(u32x4*)(Ks + (krow + 32) * 272 + kcc * 16) = rk1;
    u32x2 o0, o1, o2, o3;
    o0.x = (rv0.x & 0xffffu) | (rv1.x << 16); o0.y = (rv2.x & 0xffffu) | (rv3.x << 16);
    o1.x = (rv0.x >> 16) | (rv1.x & 0xffff0000u); o1.y = (rv2.x >> 16) | (rv3.x & 0xffff0000u);
    o2.x = (rv0.y & 0xffffu) | (rv1.y << 16); o2.y = (rv2.y & 0xffffu) | (rv3.y << 16);
    o3.x = (rv0.y >> 16) | (rv1.y & 0xffff0000u); o3.y = (rv2.y >> 16) | (rv3.y & 0xffff0000u);
    char* d = Vt + (vtc * 4) * 136 + vtt * 8;
    *(u32x2*)d = o0; *(u32x2*)(d + 136) = o1; *(u32x2*)(d + 272) = o2; *(u32x2*)(d + 408) = o3;
  };
  constexpr int NKT = 132;
  gload(0); lstore(0);
  __syncthreads();
  for (int kt = 0; kt < NKT; ++kt) {
    if (kt + 1 < NKT) gload(kt + 1);
    const char* Ks = stg + (kt & 1) * DSTAGE; const char* Vt = Ks + 17408;
#pragma unroll
    for (int kb = 0; kb < 2; ++kb) {
      f32x16 s;
#pragma unroll
      for (int i = 0; i < 16; ++i) s[i] = 0.f;
#pragma unroll
      for (int sp = 0; sp < 4; ++sp) s = mfma32(ldsfrag16(Ks + (kb * 32 + l31) * 272 + t * 128 + sp * 32 + h * 16), ldsfrag16(qrow + sp * 32), s);
#pragma unroll
      for (int i = 0; i < 16; ++i) { s[i] = __builtin_amdgcn_exp2f(s[i] - Mb); lsum += s[i]; }
#pragma unroll
      for (int ss = 0; ss < 2; ++ss) {
        u32x4 pk = {cvtpk(s[8 * ss], s[8 * ss + 1]), cvtpk(s[8 * ss + 2], s[8 * ss + 3]), cvtpk(s[8 * ss + 4], s[8 * ss + 5]), cvtpk(s[8 * ss + 6], s[8 * ss + 7])};
        const bf16x8 pf = __builtin_bit_cast(bf16x8, pk);
#pragma unroll
        for (int d = 0; d < 4; ++d) {
          const char* vb = Vt + (size_t)(d * 32 + l31) * 136 + (kb * 32 + ss * 16 + 4 * h) * 2;
          o[d] = mfma32(ldsfrag8x2(vb, vb + 16), pf, o[d]);
        }
      }
    }
    if (kt + 1 < NKT) lstore((kt + 1) & 1);
    __syncthreads();
  }
  lsum += __shfl_xor(lsum, 32);
  float* ex = (float*)smem;
  if (t == 1) {
    const float sc1 = lam / lsum;
#pragma unroll
    for (int d = 0; d < 4; ++d)
#pragma unroll
      for (int i = 0; i < 16; ++i) ex[((grp * 4 + d) * 16 + i) * 64 + lane] = o[d][i] * sc1;
  }
  __syncthreads();
  if (t == 0) {
    const float i0 = 1.f / lsum;
    float ssq = 0.f;
#pragma unroll
    for (int d = 0; d < 4; ++d)
#pragma unroll
      for (int i = 0; i < 16; ++i) { const float v = o[d][i] * i0 - ex[((grp * 4 + d) * 16 + i) * 64 + lane]; o[d][i] = v; ssq += v * v; }
    ssq += __shfl_xor(ssq, 32);
    const float rstd = rsqrtf(ssq * (1.f / 128.f) + EPS) * (1.f - LAM_INIT);
    bf16_t* hp = (bf16_t*)(WSP(p) + OFF_H) + (size_t)qtok * DM + 512 + head * 128;
    const float* sgp = PRM(p, diff_subln_g);
#pragma unroll
    for (int d = 0; d < 4; ++d)
#pragma unroll
      for (int g = 0; g < 4; ++g) {
        const int dv = d * 32 + 8 * g + 4 * h;
        const f32x4 sg = *(const f32x4*)(sgp + dv);
        u32x2 ov = {cvtpk(o[d][4 * g] * rstd * sg[0], o[d][4 * g + 1] * rstd * sg[1]), cvtpk(o[d][4 * g + 2] * rstd * sg[2], o[d][4 * g + 3] * rstd * sg[3])};
        *(u32x2*)(hp + dv) = ov;
      }
  }
  __syncthreads();
}

constexpr int NPHASE = 27;
#ifndef PHMASK
#define PHMASK 0xffff
#endif
#define EN(k) (((PHMASK) >> (k)) & 1)
__device__ __forceinline__ void run_phase(const Params& p, int ph, char* smem) {
  bf16_t* H = (bf16_t*)(WSP(p) + OFF_H);
  bf16_t* BIG = (bf16_t*)(WSP(p) + OFF_BIG);
  if (ph == 0) { if (EN(0)) phase_prep(p, smem); return; }
  const int layer = (ph - 1) / 13, s = (ph - 1) % 13;
  const float* modl = (const float*)(WSP(p) + OFF_MOD) + (size_t)layer * 5 * 9216;
  const bool last = layer == 1;
  switch (s) {
    case 0: if (EN(1)) phase_modnorm(p, layer, 0, layer == 0, TT); break;
    case 1: if (EN(2)) gemm_phase(H, DM, (const bf16_t*)(WSP(p) + OFF_W13) + (size_t)(layer * 2 + 0) * 5632 * DM, DM, TT, 5632, 0, nullptr, EpiUp{BIG}, smem); break;
    case 2: if (EN(3)) gemm_phase(BIG, DFF, (const bf16_t*)(WSP(p) + OFF_W2) + (size_t)(layer * 2 + 0) * DM * DFF, DFF, TT, DM, 0, nullptr, EpiRes{p, modl, 2, 0.5f, layer == 0}, smem); break;
    case 3: if (EN(1)) phase_modnorm(p, layer, 1, false, TT); break;
    case 4:
      if (!EN(4)) break;
      if (!last) gemm_phase(H, DM, (const bf16_t*)(WSP(p) + OFF_WABIN), DM, TT, 3200, 0, nullptr, EpiInAB{BIG, (float*)(WSP(p) + OFF_DT), PRM(p, ssd_dt_bias)}, smem);
      else gemm_phase(H, DM, (const bf16_t*)(WSP(p) + OFF_WCDIN), DM, TT, 2560, 0, nullptr, EpiBf{BIG, 2560}, smem);
      break;
    case 5: if (EN(5)) phase_mixprep(p, layer); break;
    case 6:
      if (!last) {
        for (int u = blockIdx.x; u < 2112 + 1024 + 32; u += gridDim.x) {
          if (u < 2112) { const int head = u & 7, bc = u >> 3; if (EN(6)) ssdA_unit(p, bc / 66, bc % 66, head, smem); }
          else if (u < 3136) { const int v = u - 2112, hq = v & 1, br = v >> 1; if (EN(7)) na_unit(p, br >> 7, (br >> 7) * 8192 + (br & 127) * 64, hq, br & 127, smem); }
          else { const int v = u - 3136, hq = v & 1, qb = (v >> 1) & 3, b = v >> 3; if (EN(7)) na_unit(p, b, TL + b * 256 + qb * 64, hq, -1, smem); }
        }
      } else {
        for (int u = blockIdx.x; u < 2112; u += gridDim.x) { const int nb = u & 7, bc = u >> 3; if (EN(8)) lru_unit(p, bc / 66, bc % 66, nb, 0, smem); }
      }
      break;
    case 7: if (EN(9)) { if (!last) phase_ssdB(p); else phase_lruY(p); } break;
    case 8:
      if (!last) {
        for (int u = blockIdx.x; u < 2112; u += gridDim.x) { const int head = u & 7, bc = u >> 3; if (EN(10)) ssdC_unit(p, bc / 66, bc % 66, head, smem); }
      } else {
        for (int u = blockIdx.x; u < 1024 + 2048; u += gridDim.x) {
          if (u < 1024) { if (EN(11)) diff_unit(p, u >> 8, (u >> 6) & 3, u & 63, smem); }
          else { const int v = u - 1024, nb = v & 7, bc = v >> 3; if (EN(8)) lru_unit(p, bc >> 6, 2 + (bc & 63), nb, 1, smem); }
        }
      }
      break;
    case 9:
      if (!EN(12)) break;
      if (!last) gemm_phase(H, DM, (const bf16_t*)(WSP(p) + OFF_WABOUT), DM, TT, DM, 8, (const float*)(WSP(p) + OFF_SSQ), EpiRes{p, modl, 5, 1.0f, false}, smem);
      else gemm_phase(H, DM, (const bf16_t*)(WSP(p) + OFF_WCDOUT), DM, TL, DM, 0, nullptr, EpiRes{p, modl, 5, 1.0f, false}, smem);
      break;
    case 10: if (EN(1)) phase_modnorm(p, layer, 2, false, last ? TL : TT); break;
    case 11: if (EN(2)) gemm_phase(H, DM, (const bf16_t*)(WSP(p) + OFF_W13) + (size_t)(layer * 2 + 1) * 5632 * DM, DM, last ? TL : TT, 5632, 0, nullptr, EpiUp{BIG}, smem); break;
    case 12: if (EN(3)) gemm_phase(BIG, DFF, (const bf16_t*)(WSP(p) + OFF_W2) + (size_t)(layer * 2 + 1) * DM * DFF, DFF, last ? TL : TT, DM, 0, nullptr, EpiRes{p, modl, 8, 0.5f, false}, smem); break;
  }
}

__global__ void __launch_bounds__(512) mega(Params p, int p0, int p1) {
  extern __shared__ __attribute__((aligned(16))) char smem[];
  cg::grid_group grid = cg::this_grid();
  for (int ph = p0; ph < p1; ++ph) {
    run_phase(p, ph, smem);
    if (ph + 1 < p1) {
      asm volatile("s_waitcnt vmcnt(0) lgkmcnt(0)" ::: "memory");
      grid.sync();
      __builtin_amdgcn_fence(__ATOMIC_ACQUIRE, "agent");
      asm volatile("s_waitcnt vmcnt(0)" ::: "memory");
      __syncthreads();
    }
  }
}

extern "C" void kernel_launch(void* const* d_in, const int* in_sizes, int n_in, void* d_out, int out_size, void* d_ws,
                              size_t ws_size, hipStream_t stream) {
  constexpr size_t kLds = 147456;
  static int grid_blocks = 0;
  if (!grid_blocks) {
    int dev = 0, cus = 0, per_cu = 0;
    (void)hipGetDevice(&dev);
    (void)hipDeviceGetAttribute(&cus, hipDeviceAttributeMultiprocessorCount, dev);
    (void)hipFuncSetAttribute((const void*)mega, hipFuncAttributeMaxDynamicSharedMemorySize, (int)kLds);
    (void)hipOccupancyMaxActiveBlocksPerMultiprocessor(&per_cu, mega, 512, kLds);
    if (per_cu < 1) per_cu = 1;
    grid_blocks = cus * per_cu;
  }
  Params p{};
  const float** pp = (const float**)&p;
  for (int i = 0; i < 34; ++i) pp[i] = (const float*)d_in[i];
  p.out = (float*)d_out;
  p.ws = (char*)d_ws;
  int p0 = 0, p1 = NPHASE;
  void* args[] = {&p, &p0, &p1};
  hipError_t e = hipLaunchCooperativeKernel((void*)mega, dim3(grid_blocks), dim3(512), args, kLds, stream);
  if (e != hipSuccess) fprintf(stderr, "cooperative launch failed: %s (grid %d)\n", hipGetErrorString(e), grid_blocks);
}
```

```cpp
#include <hip/hip_runtime.h>
#include <hip/hip_cooperative_groups.h>
#include <cstdio>
#include <cstddef>
namespace cg = cooperative_groups;

typedef unsigned short bf16_t;
typedef short bf16x8 __attribute__((ext_vector_type(8)));
typedef float f32x4 __attribute__((ext_vector_type(4)));
typedef float f32x16 __attribute__((ext_vector_type(16)));
typedef unsigned u32x4 __attribute__((ext_vector_type(4)));
typedef unsigned u32x2 __attribute__((ext_vector_type(2)));

#define LOG2E 1.4426950408889634f
constexpr int TL = 32768, TC = 1024, TT = TL + TC, DM = 1024, DFF = 2816;
constexpr int NT = 512;
constexpr float EPS = 1e-6f;
constexpr float LAM_INIT = 0.35550906f;

constexpr size_t al256(size_t x) { return (x + 255) & ~(size_t)255; }
constexpr size_t OFF_W13 = 0;
constexpr size_t OFF_W2 = OFF_W13 + (size_t)4 * 5632 * 1024 * 2;
constexpr size_t OFF_WABIN = OFF_W2 + (size_t)4 * 1024 * 2816 * 2;
constexpr size_t OFF_WABOUT = OFF_WABIN + (size_t)3328 * 1024 * 2;
constexpr size_t OFF_WCDIN = OFF_WABOUT + (size_t)1024 * 1024 * 2;
constexpr size_t OFF_WCDOUT = OFF_WCDIN + (size_t)2560 * 1024 * 2;
constexpr size_t OFF_WLRU = OFF_WCDOUT + (size_t)1024 * 1024 * 2;
constexpr size_t OFF_MOD = OFF_WLRU + (size_t)2 * 2 * 8 * 64 * 64 * 2;
constexpr size_t OFF_SCAL = OFF_MOD + (size_t)2 * 5 * 9216 * 4;
constexpr size_t OFF_ROPE = OFF_SCAL + 256;
constexpr size_t OFF_XC = OFF_ROPE + (size_t)192 * 16 * 2 * 4;
constexpr size_t OFF_H = OFF_XC + (size_t)TC * DM * 4;
constexpr size_t OFF_BIG = OFF_H + (size_t)TT * DM * 2;
constexpr size_t OFF_DT = OFF_BIG + (size_t)TT * 3072 * 2;
constexpr size_t OFF_XBC = OFF_DT + (size_t)TT * 16 * 4;
constexpr size_t OFF_ST = OFF_XBC + (size_t)TT * 1024 * 2;
constexpr size_t OFF_DEC = OFF_ST + (size_t)4 * 2 * 8 * 66 * 64 * 128 * 2;
constexpr size_t OFF_SSQ = al256(OFF_DEC + (size_t)4 * 2 * 8 * 66 * 4);
constexpr size_t OFF_LCA = OFF_SSQ + (size_t)TT * 16 * 4;
constexpr size_t OFF_LCH = OFF_LCA + (size_t)4 * 2 * 66 * 512 * 4;
constexpr size_t OFF_LHIN = OFF_LCH + (size_t)4 * 2 * 66 * 512 * 4;
constexpr size_t WS_END = OFF_LHIN + (size_t)4 * 2 * 66 * 512 * 4;
constexpr size_t OFF_BAR = al256(WS_END);
constexpr size_t OFF_PART = al256(OFF_BAR + 4096);
static_assert(OFF_PART + (size_t)2 * TC * DM * 4 <= (size_t)536870912, "workspace too large");

struct Params {
  const float *x, *c, *ctx, *c_ctx, *w_mod, *b_mod, *norm_g, *ffn_w1, *ffn_w3, *ffn_w2, *ab_w_in, *ab_w_out, *na_q_g,
      *na_k_g, *na_rpb, *ssd_conv_w, *ssd_conv_b, *ssd_dt_bias, *ssd_a_log, *ssd_d, *ssd_norm_g, *cd_w_in, *cd_w_out,
      *lru_conv_w, *lru_conv_b, *lru_wa, *lru_ba, *lru_wx, *lru_bx, *lru_lambda, *diff_q_g, *diff_k_g, *diff_lambda,
      *diff_subln_g;
  float* out;
  char* ws;
};

typedef __attribute__((address_space(1))) char gchar_t;
typedef __attribute__((address_space(1))) float gfloat_t;
typedef __attribute__((address_space(1))) const float gcfloat_t;
__device__ __forceinline__ unsigned long long karg_u64(int off) {
  unsigned long long a = (unsigned long long)__builtin_amdgcn_kernarg_segment_ptr();
  asm volatile("" : "+s"(a));
  return *(const __attribute__((address_space(4))) unsigned long long*)(a + (unsigned long long)off);
}
#define WSP(p) ((char*)(gchar_t*)karg_u64((int)offsetof(Params, ws)))
#define OUTP(p) ((float*)(gfloat_t*)karg_u64((int)offsetof(Params, out)))
#define PRM(p, f) ((const float*)(gcfloat_t*)karg_u64((int)offsetof(Params, f)))
constexpr int LDS_TOTAL = 147456, LDS_WTAB = LDS_TOTAL - 256;
extern __shared__ __attribute__((aligned(16))) char smem_base[];
__device__ __forceinline__ int tidx() {
  const int key = __builtin_amdgcn_s_getreg((5 << 11) | 4) & 63;
  int wv = *(const volatile int*)(smem_base + LDS_WTAB + key * 4);
  wv = __builtin_amdgcn_readfirstlane(wv);
  int t = (wv << 6) | (int)__builtin_amdgcn_mbcnt_hi(~0u, __builtin_amdgcn_mbcnt_lo(~0u, 0u));
  asm volatile("" : "+v"(t));
  return t;
}
typedef __bf16 bf16x2_t __attribute__((ext_vector_type(2)));
typedef float f32x2_t __attribute__((ext_vector_type(2)));
__device__ __forceinline__ unsigned cvtpk(float lo, float hi) {
  f32x2_t v = {lo, hi};
  bf16x2_t b = __builtin_convertvector(v, bf16x2_t);
  return __builtin_bit_cast(unsigned, b);
}
__device__ __forceinline__ float bflo(unsigned u) { return __uint_as_float(u << 16); }
__device__ __forceinline__ float bfhi(unsigned u) { return __uint_as_float(u & 0xffff0000u); }
__device__ __forceinline__ float siluf(float v) { return v * __builtin_amdgcn_rcpf(1.f + __expf(-v)); }
__device__ __forceinline__ float sigmf(float v) { return __builtin_amdgcn_rcpf(1.f + __expf(-v)); }
__device__ __forceinline__ float softplusf(float v) { return fmaxf(v, 0.f) + log1pf(__expf(-fabsf(v))); }
__device__ __forceinline__ float gelu_tanh(float v) {
  float u = 0.7978845608028654f * (v + 0.044715f * v * v * v);
  float t = 1.f - 2.f * __builtin_amdgcn_rcpf(1.f + __expf(2.f * u));
  return 0.5f * v * (1.f + t);
}
__device__ __forceinline__ f32x16 mfma32(bf16x8 a, bf16x8 b, f32x16 c) {
  return __builtin_amdgcn_mfma_f32_32x32x16_bf16(a, b, c, 0, 0, 0);
}
__device__ __forceinline__ f32x4 mfma16(bf16x8 a, bf16x8 b, f32x4 c) {
  return __builtin_amdgcn_mfma_f32_16x16x32_bf16(a, b, c, 0, 0, 0);
}
__device__ __forceinline__ bf16x8 ldsfrag16(const char* p) { return *(const bf16x8*)p; }
__device__ __forceinline__ bf16x8 ldsfrag8x2(const char* p0, const char* p1) {
  u32x2 a = *(const u32x2*)p0, b = *(const u32x2*)p1;
  u32x4 t = {a.x, a.y, b.x, b.y};
  return __builtin_bit_cast(bf16x8, t);
}
__device__ __forceinline__ float wave_sum(float v) {
#pragma unroll
  for (int o = 32; o > 0; o >>= 1) v += __shfl_xor(v, o);
  return v;
}
__device__ __forceinline__ float wave_max(float v) {
#pragma unroll
  for (int o = 32; o > 0; o >>= 1) v = fmaxf(v, __shfl_xor(v, o));
  return v;
}
__device__ __forceinline__ int modidx(int row) { return row < TL ? (row >> 13) : 4; }
__device__ __forceinline__ float* xrow(const Params& p, int row) {
  return row < TL ? OUTP(p) + (size_t)row * DM : (float*)(WSP(p) + OFF_XC) + (size_t)(row - TL) * DM;
}
__device__ __forceinline__ const float* xinrow(const Params& p, int row) {
  return row < TL ? PRM(p, x) + (size_t)row * DM : PRM(p, ctx) + (size_t)(row - TL) * DM;
}
__device__ __forceinline__ int chunk_tok0(int b, int cc) { return cc < 2 ? TL + b * 256 + cc * 128 : b * 8192 + (cc - 2) * 128; }

template <bool SCALE>
__device__ __forceinline__ void stage_T(const bf16_t* src, int ld, int nt, int nc, char* dst, int RS, const float* wl) {
  const int nct = nc >> 2, total = (nt >> 2) * nct;
  for (int m = tidx(); m < total; m += NT) {
    const int tc = m % nct, tt = m / nct;
    const bf16_t* s = src + (size_t)(tt * 4) * ld + tc * 4;
    u32x2 v0 = *(const u32x2*)s, v1 = *(const u32x2*)(s + ld), v2 = *(const u32x2*)(s + 2 * ld), v3 = *(const u32x2*)(s + 3 * ld);
    u32x2 o0, o1, o2, o3;
    if (SCALE) {
      const float w0 = wl[tt * 4], w1 = wl[tt * 4 + 1], w2 = wl[tt * 4 + 2], w3 = wl[tt * 4 + 3];
      o0.x = cvtpk(bflo(v0.x) * w0, bflo(v1.x) * w1); o0.y = cvtpk(bflo(v2.x) * w2, bflo(v3.x) * w3);
      o1.x = cvtpk(bfhi(v0.x) * w0, bfhi(v1.x) * w1); o1.y = cvtpk(bfhi(v2.x) * w2, bfhi(v3.x) * w3);
      o2.x = cvtpk(bflo(v0.y) * w0, bflo(v1.y) * w1); o2.y = cvtpk(bflo(v2.y) * w2, bflo(v3.y) * w3);
      o3.x = cvtpk(bfhi(v0.y) * w0, bfhi(v1.y) * w1); o3.y = cvtpk(bfhi(v2.y) * w2, bfhi(v3.y) * w3);
    } else {
      o0.x = (v0.x & 0xffffu) | (v1.x << 16); o0.y = (v2.x & 0xffffu) | (v3.x << 16);
      o1.x = (v0.x >> 16) | (v1.x & 0xffff0000u); o1.y = (v2.x >> 16) | (v3.x & 0xffff0000u);
      o2.x = (v0.y & 0xffffu) | (v1.y << 16); o2.y = (v2.y & 0xffffu) | (v3.y << 16);
      o3.x = (v0.y >> 16) | (v1.y & 0xffff0000u); o3.y = (v2.y >> 16) | (v3.y & 0xffff0000u);
    }
    char* d = dst + (size_t)(tc * 4) * RS + tt * 8;
    *(u32x2*)d = o0; *(u32x2*)(d + RS) = o1; *(u32x2*)(d + 2 * RS) = o2; *(u32x2*)(d + 3 * RS) = o3;
  }
}
__device__ __forceinline__ void stage_N(const bf16_t* src, int ld, int nrows, int rowbytes, char* dst, int RS) {
  const int cpr = rowbytes >> 4, total = nrows * cpr;
  for (int m = tidx(); m < total; m += NT) {
    const int rr = m / cpr, cc = m - rr * cpr;
    *(u32x4*)(dst + (size_t)rr * RS + cc * 16) = *(const u32x4*)(src + (size_t)rr * ld + cc * 8);
  }
}

__device__ __forceinline__ void convert_weights(const Params& p, char* smem, int set, int gw, int nw) {
  const int tid = tidx(), lane = tid & 63, w = tid >> 6;
  float* tile = (float*)smem + w * (64 * 65);
  constexpr int T_FFN = 12 * 704, T_ABIN = T_FFN + 832, T_ABOUT = T_ABIN + 256, T_CDIN = T_ABOUT + 640, T_CDOUT = T_CDIN + 256,
                T_WA = T_CDOUT + 16, T_WX = T_WA + 16;
  const int nset = set == 0 ? 4224 + 1088 : 4224 + 928;
  for (int ti = gw; ti < nset; ti += nw) {
    const int t = set == 0 ? (ti < 4224 ? ti : T_FFN + (ti - 4224)) : (ti < 4224 ? 4224 + ti : T_ABOUT + (ti - 4224));
    const float* src; bf16_t* dst; int K, N, ntn, mode = 0, tl;
    if (t < T_FFN) {
      const int j = t / 704, cidx = j / 3, kind = j - cidx * 3; tl = t - j * 704;
      if (kind == 2) { src = PRM(p, ffn_w2) + (size_t)cidx * DFF * DM; dst = (bf16_t*)(WSP(p) + OFF_W2) + (size_t)cidx * DM * DFF; K = DFF; N = DM; ntn = 16; }
      else { src = (kind == 0 ? PRM(p, ffn_w1) : PRM(p, ffn_w3)) + (size_t)cidx * DM * DFF; dst = (bf16_t*)(WSP(p) + OFF_W13) + (size_t)cidx * 5632 * DM; K = DM; N = DFF; ntn = 44; mode = 1 + kind; }
    } else if (t < T_ABIN) { tl = t - T_FFN; src = PRM(p, ab_w_in); dst = (bf16_t*)(WSP(p) + OFF_WABIN); K = 1024; N = 3088; ntn = 52; }
    else if (t < T_ABOUT) { tl = t - T_ABIN; src = PRM(p, ab_w_out); dst = (bf16_t*)(WSP(p) + OFF_WABOUT); K = 1024; N = 1024; ntn = 16; mode = 3; }
    else if (t < T_CDIN) { tl = t - T_ABOUT; src = PRM(p, cd_w_in); dst = (bf16_t*)(WSP(p) + OFF_WCDIN); K = 1024; N = 2560; ntn = 40; }
    else if (t < T_CDOUT) { tl = t - T_CDIN; src = PRM(p, cd_w_out); dst = (bf16_t*)(WSP(p) + OFF_WCDOUT); K = 1024; N = 1024; ntn = 16; }
    else if (t < T_WA) { tl = t - T_CDOUT; src = PRM(p, lru_wa) + (size_t)tl * 4096; dst = (bf16_t*)(WSP(p) + OFF_WLRU) + (size_t)tl * 4096; K = 64; N = 64; ntn = 1; tl = 0; }
    else { tl = t - T_WA; src = PRM(p, lru_wx) + (size_t)tl * 4096; dst = (bf16_t*)(WSP(p) + OFF_WLRU) + (size_t)(16 + tl) * 4096; K = 64; N = 64; ntn = 1; tl = 0; }
    const int tk = tl / ntn, tn = tl - tk * ntn, k0 = tk * 64, n0 = tn * 64;
#pragma unroll 4
    for (int it = 0; it < 16; ++it) {
      const int idx = it * 64 + lane, kk = idx >> 4, n4 = (idx & 15) * 4;
      f32x4 v = {0.f, 0.f, 0.f, 0.f};
      if (n0 + n4 < N) v = __builtin_nontemporal_load((const f32x4*)(src + (size_t)(k0 + kk) * N + n0 + n4));
      float* tp = tile + kk * 65 + n4;
      tp[0] = v[0]; tp[1] = v[1]; tp[2] = v[2]; tp[3] = v[3];
    }
    __builtin_amdgcn_wave_barrier();
#pragma unroll 2
    for (int it = 0; it < 8; ++it) {
      const int idx = it * 64 + lane, nn = idx >> 3, kc = idx & 7;
      float e[8];
#pragma unroll
      for (int j = 0; j < 8; ++j) e[j] = tile[(kc * 8 + j) * 65 + nn];
      if (mode == 3 && k0 >= 512) {
#pragma unroll
        for (int j = 0; j < 8; ++j) e[j] *= PRM(p, ssd_norm_g)[k0 - 512 + kc * 8 + j];
      }
      const int n = n0 + nn;
      int rho = n;
      if (mode == 1 || mode == 2) rho = 32 * (n >> 4) + 16 * (mode - 1) + (n & 15);
      u32x4 o = {cvtpk(e[0], e[1]), cvtpk(e[2], e[3]), cvtpk(e[4], e[5]), cvtpk(e[6], e[7])};
      *(u32x4*)(dst + (size_t)rho * K + k0 + kc * 8) = o;
    }
    __builtin_amdgcn_wave_barrier();
  }
}

#ifndef PROBE_SUB
#define PROBE_SUB 0
#endif
__device__ __forceinline__ void phase_prep(const Params& p, char* smem, int sub) {
  const int tid = tidx(), lane = tid & 63, w = tid >> 6;
  float* modb = (float*)(WSP(p) + OFF_MOD);
  const int ngemv = gridDim.x >= 128 ? 64 : 0;
  for (int u = blockIdx.x; u < 64; u += (ngemv ? 64 * 1024 : gridDim.x)) {
    if (sub == 2) break;
    const int l = u >> 5, k0 = (u & 31) * 32;
    float* sl = (float*)smem;
    __syncthreads();
    if (tid < 160) {
      const int idx = tid >> 5, kk = tid & 31;
      const float v = idx < 4 ? PRM(p, c)[idx * 1024 + k0 + kk] : PRM(p, c_ctx)[k0 + kk];
      sl[tid] = v / (1.f + expf(-v));
    }
    __syncthreads();
    f32x4 acc[5][5];
#pragma unroll
    for (int a = 0; a < 5; ++a)
#pragma unroll
      for (int q = 0; q < 5; ++q) acc[a][q] = (f32x4){0.f, 0.f, 0.f, 0.f};
    const float* wbase = PRM(p, w_mod) + ((size_t)l * 1024 + k0) * 9216;
    const bool tail = tid < 256;
#pragma unroll 2
    for (int kk = 0; kk < 32; ++kk) {
      const float* rowp = wbase + (size_t)kk * 9216 + tid * 4;
      f32x4 wv[5];
#pragma unroll
      for (int q = 0; q < 4; ++q) wv[q] = __builtin_nontemporal_load((const f32x4*)(rowp + q * 2048));
      wv[4] = tail ? __builtin_nontemporal_load((const f32x4*)(rowp + 4 * 2048)) : (f32x4){0.f, 0.f, 0.f, 0.f};
#pragma unroll
      for (int a = 0; a < 5; ++a) {
        const float sv = sl[a * 32 + kk];
#pragma unroll
        for (int q = 0; q < 5; ++q) acc[a][q] += sv * wv[q];
      }
    }
    float* P = (float*)(WSP(p) + OFF_BIG) + (size_t)u * 5 * 9216;
#pragma unroll
    for (int a = 0; a < 5; ++a)
#pragma unroll
      for (int q = 0; q < 5; ++q)
        if (q < 4 || tail) *(f32x4*)(P + (size_t)a * 9216 + q * 2048 + tid * 4) = acc[a][q];
  }
  __syncthreads();
  if (blockIdx.x == gridDim.x - 1) {
    float* red = (float*)smem;
    float mr = 0.f;
#pragma unroll
    for (int q = 0; q < 8; ++q) { const int i = tid + q * NT; if (i < 8 * 15 * 31) mr = fmaxf(mr, fabsf(PRM(p, na_rpb)[i])); }
    mr = wave_max(mr);
    if (lane == 0) red[w] = mr;
    __syncthreads();
    if (w == 0) {
      float* sc = (float*)(WSP(p) + OFF_SCAL);
      mr = fmaxf(fmaxf(fmaxf(red[0], red[1]), fmaxf(red[2], red[3])), fmaxf(fmaxf(red[4], red[5]), fmaxf(red[6], red[7])));
      const float mq = wave_max(fabsf(PRM(p, na_q_g)[lane])), mk = wave_max(fabsf(PRM(p, na_k_g)[lane]));
      const float dq = wave_max(fabsf(PRM(p, diff_q_g)[lane])), dk = wave_max(fabsf(PRM(p, diff_k_g)[lane]));
      const float s1 = wave_sum(PRM(p, diff_lambda)[lane] * PRM(p, diff_lambda)[64 + lane]);
      const float s2 = wave_sum(PRM(p, diff_lambda)[128 + lane] * PRM(p, diff_lambda)[192 + lane]);
      if (lane == 0) {
        float eight = 8.f;
        asm volatile("" : "+v"(eight));
        sc[0] = (eight * mq * mk + mr) * LOG2E;
        sc[1] = eight * dq * dk * LOG2E;
        sc[2] = expf(s1) - expf(s2) + LAM_INIT;
      }
    }
    __syncthreads();
  }
  if (blockIdx.x == (gridDim.x > 1 ? gridDim.x - 2 : 0)) {
    float* rt = (float*)(WSP(p) + OFF_ROPE);
    for (int i = tid; i < 192 * 16; i += NT) {
      const int pos = i >> 4, m = i & 15;
      const float inv = exp2f(-(float)m * (13.287712379549449f / 16.f));
      const float ang = (float)(pos < 128 ? pos : pos - 128) * inv;
      float sn, cs;
      sincosf(ang, &sn, &cs);
      rt[i * 2] = cs; rt[i * 2 + 1] = sn;
    }
  }
  if (sub != 1) {
    if (ngemv == 0) convert_weights(p, smem, 0, blockIdx.x * 8 + w, gridDim.x * 8);
    else if ((int)blockIdx.x >= 64) convert_weights(p, smem, 0, ((int)blockIdx.x - 64) * 8 + w, ((int)gridDim.x - 64) * 8);
  }
}

__device__ __forceinline__ void phase_modreduce(const Params& p) {
  const float* P = (const float*)(WSP(p) + OFF_BIG);
  float* modb = (float*)(WSP(p) + OFF_MOD);
  const int gtid = blockIdx.x * NT + tidx(), gsz = gridDim.x * NT;
  for (int o = gtid; o < 2 * 5 * 2304; o += gsz) {
    const int l = o / (5 * 2304), r = o - l * 5 * 2304, idx = r / 2304, f = r - idx * 2304;
    f32x4 acc = *(const f32x4*)(PRM(p, b_mod) + (size_t)l * 9216 + f * 4);
#pragma unroll 8
    for (int sl = 0; sl < 32; ++sl) acc += *(const f32x4*)(P + ((size_t)(l * 32 + sl) * 5 + idx) * 9216 + f * 4);
    *(f32x4*)(modb + ((size_t)l * 5 + idx) * 9216 + f * 4) = acc;
  }
}

__device__ __forceinline__ void phase_modnorm(const Params& p, int layer, int k, bool from_input, int nrows, bool fold) {
  const int lane = tidx() & 63, w = tidx() >> 6;
  const float* g = PRM(p, norm_g) + ((size_t)layer * 3 + k) * DM;
  const float* modb = (const float*)(WSP(p) + OFF_MOD) + (size_t)layer * 5 * 9216;
  bf16_t* H = (bf16_t*)(WSP(p) + OFF_H);
  const int stride = gridDim.x * 8;
  for (int row0 = blockIdx.x * 8 + w; row0 < nrows; row0 += 2 * stride) {
    const int row1 = row0 + stride;
    const bool has1 = row1 < nrows;
    const float* xr0 = from_input ? xinrow(p, row0) : xrow(p, row0);
    const float* xr1 = has1 ? (from_input ? xinrow(p, row1) : xrow(p, row1)) : xr0;
    f32x4 v0[4], v1[4];
#pragma unroll
    for (int i = 0; i < 4; ++i) { v0[i] = *(const f32x4*)(xr0 + i * 256 + lane * 4); v1[i] = *(const f32x4*)(xr1 + i * 256 + lane * 4); }
    if (fold) {
      const float* P = (const float*)(WSP(p) + OFF_PART);
      if (row0 >= TL) {
        float* xw = (float*)(WSP(p) + OFF_XC) + (size_t)(row0 - TL) * DM;
#pragma unroll
        for (int i = 0; i < 4; ++i) {
          const size_t o = (size_t)(row0 - TL) * DM + i * 256 + lane * 4;
          v0[i] += *(const f32x4*)(P + o) + *(const f32x4*)(P + (size_t)TC * DM + o);
          *(f32x4*)(xw + i * 256 + lane * 4) = v0[i];
        }
      }
      if (has1 && row1 >= TL) {
        float* xw = (float*)(WSP(p) + OFF_XC) + (size_t)(row1 - TL) * DM;
#pragma unroll
        for (int i = 0; i < 4; ++i) {
          const size_t o = (size_t)(row1 - TL) * DM + i * 256 + lane * 4;
          v1[i] += *(const f32x4*)(P + o) + *(const f32x4*)(P + (size_t)TC * DM + o);
          *(f32x4*)(xw + i * 256 + lane * 4) = v1[i];
        }
      }
    }
    float s0 = 0.f, s1 = 0.f;
#pragma unroll
    for (int i = 0; i < 4; ++i) {
      s0 += v0[i][0] * v0[i][0] + v0[i][1] * v0[i][1] + v0[i][2] * v0[i][2] + v0[i][3] * v0[i][3];
      s1 += v1[i][0] * v1[i][0] + v1[i][1] * v1[i][1] + v1[i][2] * v1[i][2] + v1[i][3] * v1[i][3];
    }
    s0 = wave_sum(s0); s1 = wave_sum(s1);
    const float r0 = rsqrtf(s0 * (1.f / 1024.f) + EPS), r1 = rsqrtf(s1 * (1.f / 1024.f) + EPS);
    const float* m0 = modb + (size_t)modidx(row0) * 9216 + (3 * k) * 1024;
    const float* m1 = modb + (size_t)modidx(has1 ? row1 : row0) * 9216 + (3 * k) * 1024;
#pragma unroll
    for (int i = 0; i < 4; ++i) {
      const int col = i * 256 + lane * 4;
      const f32x4 gg = *(const f32x4*)(g + col);
      const f32x4 sh0 = *(const f32x4*)(m0 + col), sc0 = *(const f32x4*)(m0 + 1024 + col);
      float o[4];
#pragma unroll
      for (int jx = 0; jx < 4; ++jx) o[jx] = (v0[i][jx] * r0 * gg[jx]) * (1.f + sc0[jx]) + sh0[jx];
      u32x2 pk = {cvtpk(o[0], o[1]), cvtpk(o[2], o[3])};
      *(u32x2*)(H + (size_t)row0 * DM + col) = pk;
      if (has1) {
        const f32x4 sh1 = *(const f32x4*)(m1 + col), sc1 = *(const f32x4*)(m1 + 1024 + col);
#pragma unroll
        for (int jx = 0; jx < 4; ++jx) o[jx] = (v1[i][jx] * r1 * gg[jx]) * (1.f + sc1[jx]) + sh1[jx];
        u32x2 pk1 = {cvtpk(o[0], o[1]), cvtpk(o[2], o[3])};
        *(u32x2*)(H + (size_t)row1 * DM + col) = pk1;
      }
    }
  }
}

constexpr int G_STAGE = 55296;
template <class Epi>
__device__ __forceinline__ void gemm_phase(const bf16_t* A, int lda, const bf16_t* Bt, int K, int Mrows, int N, int koff,
                                           const float* ssq, Epi epi, char* smem) {
  const int tid = tidx(), lane = tid & 63, w = tid >> 6, wr = w >> 1, wc = w & 1, r = lane & 15, q = lane >> 4;
  const int nN = N / 128, nunits = (Mrows / 256) * nN, nk = K / 64;
  const int lrow = tid >> 3, lkc = tid & 7;
  for (int unit = blockIdx.x; unit < nunits; unit += gridDim.x) {
    const int pm = unit / nN, pn = unit - pm * nN;
    const int row0 = pm * 256, col0 = pn * 128;
    f32x4 acc[4][4];
#pragma unroll
    for (int mi = 0; mi < 4; ++mi)
#pragma unroll
      for (int ni = 0; ni < 4; ++ni) acc[mi][ni] = (f32x4){0.f, 0.f, 0.f, 0.f};
    const bf16_t* gA = A + (size_t)(row0 + lrow) * lda + lkc * 8;
    const bf16_t* gB = Bt + (size_t)(col0 + lrow) * K + lkc * 8;
    u32x4 ra[4], rb[2];
    {
      const int kt = koff;
#pragma unroll
      for (int i = 0; i < 4; ++i) ra[i] = *(const u32x4*)(gA + (size_t)i * 64 * lda + kt * 64);
#pragma unroll
      for (int i = 0; i < 2; ++i) rb[i] = *(const u32x4*)(gB + (size_t)i * 64 * K + kt * 64);
      char* sa = smem;
#pragma unroll
      for (int i = 0; i < 4; ++i) *(u32x4*)(sa + (lrow + i * 64) * 144 + lkc * 16) = ra[i];
#pragma unroll
      for (int i = 0; i < 2; ++i) *(u32x4*)(sa + 36864 + (lrow + i * 64) * 144 + lkc * 16) = rb[i];
    }
    __syncthreads();
    for (int it = 0; it < nk; ++it) {
      if (it + 1 < nk) {
        int kt = it + 1 + koff; if (kt >= nk) kt -= nk;
#pragma unroll
        for (int i = 0; i < 4; ++i) ra[i] = *(const u32x4*)(gA + (size_t)i * 64 * lda + kt * 64);
#pragma unroll
        for (int i = 0; i < 2; ++i) rb[i] = *(const u32x4*)(gB + (size_t)i * 64 * K + kt * 64);
      }
      const char* sa = smem + (it & 1) * G_STAGE;
      const char* sb = sa + 36864;
#pragma unroll
      for (int ks = 0; ks < 2; ++ks) {
        bf16x8 af[4], bfr[4];
#pragma unroll
        for (int mi = 0; mi < 4; ++mi) af[mi] = ldsfrag16(sa + (wr * 64 + mi * 16 + r) * 144 + ks * 64 + q * 16);
#pragma unroll
        for (int ni = 0; ni < 4; ++ni) bfr[ni] = ldsfrag16(sb + (wc * 64 + ni * 16 + r) * 144 + ks * 64 + q * 16);
#pragma unroll
        for (int mi = 0; mi < 4; ++mi)
#pragma unroll
          for (int ni = 0; ni < 4; ++ni) acc[mi][ni] = mfma16(bfr[ni], af[mi], acc[mi][ni]);
      }
      if (ssq != nullptr && it == 7) {
#pragma unroll
        for (int mi = 0; mi < 4; ++mi) {
          const float* sp = ssq + (size_t)(row0 + wr * 64 + mi * 16 + r) * 16;
          const f32x4 s0 = *(const f32x4*)sp, s1 = *(const f32x4*)(sp + 4), s2 = *(const f32x4*)(sp + 8), s3 = *(const f32x4*)(sp + 12);
          const float tot = (s0[0] + s0[1] + s0[2] + s0[3]) + (s1[0] + s1[1] + s1[2] + s1[3]) + (s2[0] + s2[1] + s2[2] + s2[3]) + (s3[0] + s3[1] + s3[2] + s3[3]);
          const float rs = rsqrtf(tot * (1.f / 512.f) + EPS);
#pragma unroll
          for (int ni = 0; ni < 4; ++ni) acc[mi][ni] *= rs;
        }
      }
      if (it + 1 < nk) {
        char* da = smem + ((it + 1) & 1) * G_STAGE;
#pragma unroll
        for (int i = 0; i < 4; ++i) *(u32x4*)(da + (lrow + i * 64) * 144 + lkc * 16) = ra[i];
#pragma unroll
        for (int i = 0; i < 2; ++i) *(u32x4*)(da + 36864 + (lrow + i * 64) * 144 + lkc * 16) = rb[i];
      }
      __syncthreads();
    }
    epi(acc, row0 + wr * 64, col0 + wc * 64, r, q);
  }
}

struct EpiUp {
  bf16_t* G;
  __device__ __forceinline__ void operator()(f32x4 (&acc)[4][4], int rowb, int colb, int r, int q) const {
#pragma unroll
    for (int mi = 0; mi < 4; ++mi) {
      const int row = rowb + mi * 16 + r;
#pragma unroll
      for (int pr = 0; pr < 2; ++pr) {
        const f32x4 g = acc[mi][2 * pr], u = acc[mi][2 * pr + 1];
        const int col = (colb >> 1) + pr * 16 + 4 * q;
        u32x2 o = {cvtpk(siluf(g[0]) * u[0], siluf(g[1]) * u[1]), cvtpk(siluf(g[2]) * u[2], siluf(g[3]) * u[3])};
        *(u32x2*)(G + (size_t)row * DFF + col) = o;
      }
    }
  }
};
struct EpiRes {
  Params p; const float* modl; int gate; float scale; bool from_input; int rowoff;
  __device__ __forceinline__ void operator()(f32x4 (&acc)[4][4], int rowb, int colb, int r, int q) const {
#pragma unroll
    for (int mi = 0; mi < 4; ++mi) {
      const int row = rowoff + rowb + mi * 16 + r;
      const float* src = from_input ? xinrow(p, row) : xrow(p, row);
      float* dst = xrow(p, row);
      const float* mrow = modl + (size_t)modidx(row) * 9216 + gate * 1024;
#pragma unroll
      for (int ni = 0; ni < 4; ++ni) {
        const int col = colb + ni * 16 + 4 * q;
        const f32x4 s = *(const f32x4*)(src + col), m = *(const f32x4*)(mrow + col);
        f32x4 o;
#pragma unroll
        for (int j = 0; j < 4; ++j) o[j] = s[j] + scale * m[j] * acc[mi][ni][j];
        *(f32x4*)(dst + col) = o;
      }
    }
  }
};
struct EpiInAB {
  bf16_t* U; float* DT; const float* dtb;
  __device__ __forceinline__ void operator()(f32x4 (&acc)[4][4], int rowb, int colb, int r, int q) const {
#pragma unroll
    for (int mi = 0; mi < 4; ++mi) {
      const int row = rowb + mi * 16 + r;
#pragma unroll
      for (int ni = 0; ni < 4; ++ni) {
        const int col = colb + ni * 16 + 4 * q;
        if (col < 3072) {
          u32x2 o = {cvtpk(acc[mi][ni][0], acc[mi][ni][1]), cvtpk(acc[mi][ni][2], acc[mi][ni][3])};
          *(u32x2*)(U + (size_t)row * 3072 + col) = o;
        } else if (col < 3088) {
          f32x4 o;
#pragma unroll
          for (int j = 0; j < 4; ++j) o[j] = softplusf(acc[mi][ni][j] + dtb[col - 3072 + j]);
          *(f32x4*)(DT + (size_t)row * 16 + col - 3072) = o;
        }
      }
    }
  }
};
struct EpiBf {
  bf16_t* U; int ld;
  __device__ __forceinline__ void operator()(f32x4 (&acc)[4][4], int rowb, int colb, int r, int q) const {
#pragma unroll
    for (int mi = 0; mi < 4; ++mi) {
      const int row = rowb + mi * 16 + r;
#pragma unroll
      for (int ni = 0; ni < 4; ++ni) {
        const int col = colb + ni * 16 + 4 * q;
        u32x2 o = {cvtpk(acc[mi][ni][0], acc[mi][ni][1]), cvtpk(acc[mi][ni][2], acc[mi][ni][3])};
        *(u32x2*)(U + (size_t)row * ld + col) = o;
      }
    }
  }
};

namespace pg8 {
#define PG8_LAS __attribute__((address_space(3)))
typedef unsigned short bf16_t;
typedef short bf16x8 __attribute__((ext_vector_type(8)));
typedef float f32x4 __attribute__((ext_vector_type(4)));
typedef unsigned u32x4 __attribute__((ext_vector_type(4)));
constexpr int BM = 256, BK = 64, HALF = 128, HTB = HALF * BK * 2  , STAGE_BYTES = 8 * HTB, NXCD = 8, WGM = 8;

__host__ __device__ __forceinline__ int lds_byte(int r, int c) { const int st = (r >> 4) * 2 + (c >> 5), rr = r & 15, cc = c & 31, ob = rr * 64 + cc * 2; return st * 1024 + (ob ^ (((ob >> 9) & 1) << 5)); }
__host__ __device__ __forceinline__ void stage_rc(int b, int& R, int& C) { const int st = b / 1024, sb = b % 1024, swz = sb ^ (((sb >> 9) & 1) << 5); R = (st >> 1) * 16 + swz / 64; C = (st & 1) * 32 + (swz % 64) / 2; }
__host__ __device__ __forceinline__ int perm32(int rho) { const int n = rho >> 4, i = rho & 15; return 8 * (i >> 2) + 4 * n + (i & 3); }

struct Unit { int pm, pn; };
struct Gemm { const bf16_t* A; const bf16_t* Bt; int M, N, K, ld; };

struct StaticOrder {
    int nM, nN, nwg, G, c;
    __host__ __device__ void init(int M, int N, int G_, int c_) { nM = M / BM; nN = N / BM; nwg = nM * nN; G = G_; c = c_; }
    __host__ __device__ bool next(int i, Unit& u) const {
        const long L = (long)i * G + c; if (L >= nwg) return false;
        int wgid = (int)L; { const int q = nwg / NXCD, r = nwg % NXCD, xcd = wgid % NXCD, off = wgid / NXCD; wgid = (xcd < r ? xcd * (q + 1) : r * (q + 1) + (xcd - r) * q) + off; }
        const int nig = WGM * nN, gid = wgid / nig, fm = gid * WGM, gsz = (nM - fm) < WGM ? (nM - fm) : WGM;
        u.pm = fm + ((wgid % nig) % gsz); u.pn = (wgid % nig) / gsz; return true;
    }
    __device__ __forceinline__ void a_ready(const Unit&) const {}
    __device__ __forceinline__ void done(const Unit&) const {}
};
template <class Epi, class Sched, bool STAMP = false>
__device__ __forceinline__ void gemm_phase(PG8_LAS unsigned char* lds, const Gemm g, const Sched& S, const Epi& E, unsigned long long* stamps) {
    const int tid = tidx(), wid = __builtin_amdgcn_readfirstlane(tid >> 6), lane = tid & 63, wr = wid >> 2, wc = wid & 3, fr = lane & 15, fq = lane >> 4;
    const int K = g.ld, nt = g.K / BK;
    int ts_lo = 0, ts_hi = 0, nts = 0; const unsigned long long rt_entry = STAMP ? (unsigned long long)wall_clock64() : 0ull;
#define PG8_STAMP() do { if (STAMP && wid == 0 && nts < 64) { const unsigned long long _c = (unsigned long long)clock64(); \
        ts_lo = (lane == nts) ? (int)(unsigned)_c : ts_lo; ts_hi = (lane == nts) ? (int)(unsigned)(_c >> 32) : ts_hi; ++nts; } } while (0)
    PG8_STAMP();
    unsigned voffA[2], voffB[2];
#pragma unroll
    for (int i = 0; i < 2; ++i) { int R, C; stage_rc(tid * 16 + i * 8192, R, C); const int Rb = Epi::PERM ? ((R & ~31) + perm32(R & 31)) : R;
        voffA[i] = (unsigned)(R * K + C) * 2u; voffB[i] = (unsigned)(Rb * K + C) * 2u; }
    const size_t kstep = (size_t)(BK * 2);
    const size_t hstep = (size_t)HALF * K * 2;
    const size_t tstep = 2 * hstep;
    const unsigned ldsw = (unsigned)wid * 1024u;
    const int aoff = lds_byte(wr * 64 + fr, fq * 8), boff = lds_byte(wc * 32 + fr, fq * 8);
#define PG8_SA(b, h) (((b) * 2 + (h)) * HTB)
#define PG8_SB(b, h) ((4 + (b) * 2 + (h)) * HTB)
#define PG8_STAGE(bufoff, gbase, voff) do { _Pragma("unroll") for (int _i = 0; _i < 2; ++_i) \
        __builtin_amdgcn_global_load_lds((const unsigned*)((const char*)(gbase) + (voff)[_i]), (PG8_LAS unsigned*)(lds + (bufoff) + ldsw + _i * 8192), 16, 0, 0); } while (0)
#define PG8_LDA(dst, b, h) do { _Pragma("unroll") for (int m = 0; m < 4; ++m) _Pragma("unroll") for (int k = 0; k < 2; ++k) dst[m][k] = *(const PG8_LAS bf16x8*)(lds + PG8_SA(b, h) + aoff + m * 2048 + k * 1024); } while (0)
#define PG8_LDB(dst, b, h) do { _Pragma("unroll") for (int n = 0; n < 2; ++n) _Pragma("unroll") for (int k = 0; k < 2; ++k) dst[n][k] = *(const PG8_LAS bf16x8*)(lds + PG8_SB(b, h) + boff + n * 2048 + k * 1024); } while (0)
#define PG8_MMA(ai, bj, At, Bt) do { __builtin_amdgcn_s_setprio(1); _Pragma("unroll") for (int m = 0; m < 4; ++m) _Pragma("unroll") for (int n = 0; n < 2; ++n) _Pragma("unroll") for (int k = 0; k < 2; ++k) \
        acc[ai][bj][m][n] = __builtin_amdgcn_mfma_f32_16x16x32_bf16(Bt[n][k], At[m][k], acc[ai][bj][m][n], 0, 0, 0); __builtin_amdgcn_s_setprio(0); } while (0)
#define PG8_WAIT_V(n) asm volatile("s_waitcnt vmcnt(" #n ")" ::: "memory")
#define PG8_WAIT_L(n) asm volatile("s_waitcnt lgkmcnt(" #n ")" ::: "memory")
#define PG8_BAR __builtin_amdgcn_s_barrier()
#define PG8_SCHED __builtin_amdgcn_sched_barrier(0)
    Unit cur, nxt; int ui = 0;
    if (!S.next(0, cur)) return;
    f32x4 acc[2][2][4][2];
#pragma unroll
    for (int a = 0; a < 2; ++a)
#pragma unroll
        for (int b = 0; b < 2; ++b)
#pragma unroll
            for (int m = 0; m < 4; ++m)
#pragma unroll
                for (int n = 0; n < 2; ++n) acc[a][b][m][n] = (f32x4){0.f, 0.f, 0.f, 0.f};
    bf16x8 At[4][2], B0[2][2], B1[2][2];
    const char* cA = (const char*)g.A + (size_t)cur.pm * tstep; const char* cB = (const char*)g.Bt + (size_t)cur.pn * tstep;
    S.a_ready(cur);
    PG8_STAGE(PG8_SB(0, 0), cB, voffB); PG8_STAGE(PG8_SA(0, 0), cA, voffA); PG8_STAGE(PG8_SB(0, 1), cB + hstep, voffB); PG8_STAGE(PG8_SA(0, 1), cA + hstep, voffA);
    if (wr == 1) PG8_BAR;
    PG8_WAIT_V(4); PG8_BAR;
    PG8_STAGE(PG8_SB(1, 0), cB + kstep, voffB); PG8_STAGE(PG8_SA(1, 0), cA + kstep, voffA); PG8_STAGE(PG8_SB(1, 1), cB + hstep + kstep, voffB);
    PG8_WAIT_V(6); PG8_BAR;
    PG8_STAMP();
    for (;;) {
        const bool has_next = S.next(ui + 1, nxt);
        const char* nA = has_next ? (const char*)g.A + (size_t)nxt.pm * tstep : cA; const char* nB = has_next ? (const char*)g.Bt + (size_t)nxt.pn * tstep : cB;
        for (int t = 0; t < nt; t += 2) {
            const bool last = (t == nt - 2);
            const char* a1 = cA + (size_t)(t + 1) * kstep;
            const char* a2 = last ? nA : cA + (size_t)(t + 2) * kstep; const char* b2 = last ? nB : cB + (size_t)(t + 2) * kstep;
            const char* a3 = a2 + kstep; const char* b3 = b2 + kstep;
            if (last && has_next) S.a_ready(nxt);
            PG8_LDB(B0, 0, 0); PG8_SCHED; PG8_LDA(At, 0, 0); PG8_STAGE(PG8_SA(1, 1), a1 + hstep, voffA);
            PG8_WAIT_L(8); PG8_BAR; PG8_WAIT_L(0); PG8_MMA(0, 0, At, B0); PG8_BAR; PG8_SCHED;
            PG8_LDB(B1, 0, 1); PG8_STAGE(PG8_SB(0, 0), b2, voffB);
            PG8_BAR; PG8_WAIT_L(0); PG8_MMA(0, 1, At, B1); PG8_BAR;
            PG8_LDA(At, 0, 1); PG8_STAGE(PG8_SA(0, 0), a2, voffA);
            PG8_BAR; PG8_WAIT_L(0); PG8_MMA(1, 0, At, B0); PG8_BAR; PG8_SCHED;
            PG8_STAGE(PG8_SB(0, 1), b2 + hstep, voffB);
            PG8_WAIT_V(6); PG8_BAR; PG8_MMA(1, 1, At, B1); PG8_BAR;
            PG8_LDB(B0, 1, 0); PG8_SCHED; PG8_LDA(At, 1, 0); PG8_STAGE(PG8_SA(0, 1), a2 + hstep, voffA);
            PG8_WAIT_L(8); PG8_BAR; PG8_WAIT_L(0); PG8_MMA(0, 0, At, B0); PG8_BAR; PG8_SCHED;
            PG8_LDB(B1, 1, 1); PG8_STAGE(PG8_SB(1, 0), b3, voffB);
            PG8_BAR; PG8_WAIT_L(0); PG8_MMA(0, 1, At, B1); PG8_BAR;
            PG8_LDA(At, 1, 1); PG8_STAGE(PG8_SA(1, 0), a3, voffA);
            PG8_BAR; PG8_WAIT_L(0); PG8_MMA(1, 0, At, B0); PG8_BAR; PG8_SCHED;
            PG8_STAGE(PG8_SB(1, 1), b3 + hstep, voffB);
            PG8_WAIT_V(6); PG8_BAR; PG8_MMA(1, 1, At, B1); PG8_BAR;
        }
        PG8_STAMP();
        if constexpr (!Epi::AFTER_DRAIN) { E(acc, cur, wr, wc, fr, fq); S.done(cur); }
        PG8_STAMP();
        if (!has_next) break;
#pragma unroll
        for (int a = 0; a < 2; ++a)
#pragma unroll
            for (int b = 0; b < 2; ++b)
#pragma unroll
                for (int m = 0; m < 4; ++m)
#pragma unroll
                    for (int n = 0; n < 2; ++n) acc[a][b][m][n] = (f32x4){0.f, 0.f, 0.f, 0.f};
        cur = nxt; cA = nA; cB = nB; ++ui;
    }
    PG8_WAIT_V(0);
    if (wr == 0) PG8_BAR;
    PG8_BAR;
    if constexpr (Epi::AFTER_DRAIN) { E.fused(acc, cur, wr, wc, fr, fq, lds, wid, lane); S.done(cur); }
    PG8_STAMP();
    if (STAMP && wid == 0) { stamps[lane] = lane < nts ? (((unsigned long long)(unsigned)ts_hi << 32) | (unsigned)ts_lo) : 0ull;
        if (lane == 62) stamps[62] = rt_entry; if (lane == 63) stamps[63] = (unsigned long long)wall_clock64(); }
#undef PG8_STAMP
#undef PG8_SA
#undef PG8_SB
#undef PG8_STAGE
#undef PG8_LDA
#undef PG8_LDB
#undef PG8_MMA
#undef PG8_WAIT_V
#undef PG8_WAIT_L
#undef PG8_BAR
#undef PG8_SCHED
}
}

struct Epi8Up {
  static constexpr bool PERM = false, AFTER_DRAIN = false;
  bf16_t* G;
  __device__ __forceinline__ void operator()(const f32x4 (&acc)[2][2][4][2], const pg8::Unit& u, int wr, int wc, int fr, int fq) const {
#pragma unroll
    for (int ai = 0; ai < 2; ++ai)
#pragma unroll
      for (int m = 0; m < 4; ++m) {
        const int row = u.pm * 256 + ai * 128 + wr * 64 + m * 16 + fr;
#pragma unroll
        for (int bj = 0; bj < 2; ++bj) {
          const f32x4 g = acc[ai][bj][m][0], v = acc[ai][bj][m][1];
          const int col = ((u.pn * 256 + bj * 128 + wc * 32) >> 1) + 4 * fq;
          u32x2 o = {cvtpk(siluf(g[0]) * v[0], siluf(g[1]) * v[1]), cvtpk(siluf(g[2]) * v[2], siluf(g[3]) * v[3])};
          *(u32x2*)(G + (size_t)row * DFF + col) = o;
        }
      }
  }
};
struct Epi8Res {
  static constexpr bool PERM = false, AFTER_DRAIN = false;
  Params p; const float* modl; int gate; float scale; bool from_input;
  __device__ __forceinline__ void operator()(const f32x4 (&acc)[2][2][4][2], const pg8::Unit& u, int wr, int wc, int fr, int fq) const {
#pragma unroll
    for (int ai = 0; ai < 2; ++ai)
#pragma unroll
      for (int m = 0; m < 4; ++m) {
        const int row = u.pm * 256 + ai * 128 + wr * 64 + m * 16 + fr;
        const float* src = from_input ? xinrow(p, row) : xrow(p, row);
        float* dst = xrow(p, row);
        const float* mrow = modl + (size_t)modidx(row) * 9216 + gate * 1024;
#pragma unroll
        for (int bj = 0; bj < 2; ++bj)
#pragma unroll
          for (int n = 0; n < 2; ++n) {
            const int col = u.pn * 256 + bj * 128 + wc * 32 + n * 16 + 4 * fq;
            const f32x4 sv = *(const f32x4*)(src + col), mv = *(const f32x4*)(mrow + col);
            f32x4 o;
#pragma unroll
            for (int j = 0; j < 4; ++j) o[j] = sv[j] + scale * mv[j] * acc[ai][bj][m][n][j];
            *(f32x4*)(dst + col) = o;
          }
      }
  }
};
struct Epi8InAB {
  static constexpr bool PERM = false, AFTER_DRAIN = false;
  bf16_t* U; float* DT; const float* dtb;
  __device__ __forceinline__ void operator()(const f32x4 (&acc)[2][2][4][2], const pg8::Unit& u, int wr, int wc, int fr, int fq) const {
#pragma unroll
    for (int ai = 0; ai < 2; ++ai)
#pragma unroll
      for (int m = 0; m < 4; ++m) {
        const int row = u.pm * 256 + ai * 128 + wr * 64 + m * 16 + fr;
#pragma unroll
        for (int bj = 0; bj < 2; ++bj)
#pragma unroll
          for (int n = 0; n < 2; ++n) {
            const int col = u.pn * 256 + bj * 128 + wc * 32 + n * 16 + 4 * fq;
            const f32x4 a = acc[ai][bj][m][n];
            if (col < 3072) {
              u32x2 o = {cvtpk(a[0], a[1]), cvtpk(a[2], a[3])};
              *(u32x2*)(U + (size_t)row * 3072 + col) = o;
            } else if (col < 3088) {
              f32x4 o;
#pragma unroll
              for (int j = 0; j < 4; ++j) o[j] = softplusf(a[j] + dtb[col - 3072 + j]);
              *(f32x4*)(DT + (size_t)row * 16 + col - 3072) = o;
            }
          }
      }
  }
};
struct Epi8Bf {
  static constexpr bool PERM = false, AFTER_DRAIN = false;
  bf16_t* U; int ld;
  __device__ __forceinline__ void operator()(const f32x4 (&acc)[2][2][4][2], const pg8::Unit& u, int wr, int wc, int fr, int fq) const {
#pragma unroll
    for (int ai = 0; ai < 2; ++ai)
#pragma unroll
      for (int m = 0; m < 4; ++m) {
        const int row = u.pm * 256 + ai * 128 + wr * 64 + m * 16 + fr;
#pragma unroll
        for (int bj = 0; bj < 2; ++bj)
#pragma unroll
          for (int n = 0; n < 2; ++n) {
            const int col = u.pn * 256 + bj * 128 + wc * 32 + n * 16 + 4 * fq;
            const f32x4 a = acc[ai][bj][m][n];
            u32x2 o = {cvtpk(a[0], a[1]), cvtpk(a[2], a[3])};
            *(u32x2*)(U + (size_t)row * ld + col) = o;
          }
      }
  }
};
template <class Epi>
__device__ __forceinline__ void gemm8(const bf16_t* A, const bf16_t* Bt, int M, int N, int K, const Epi& E, char* smem, int ld = 0, int rot = 0) {
  const int G = (int)gridDim.x;
  pg8::StaticOrder S; S.init(M, N, G, ((int)blockIdx.x + G - rot % G) % G);
  pg8::Gemm g{A, Bt, M, N, K, ld ? ld : K};
  pg8::gemm_phase<Epi, pg8::StaticOrder, false>((PG8_LAS unsigned char*)smem, g, S, E, nullptr);
  __syncthreads();
}
struct Epi8Part {
  static constexpr bool PERM = false, AFTER_DRAIN = false;
  float* P; const float* modl; int gate; float scale;
  __device__ __forceinline__ void operator()(const f32x4 (&acc)[2][2][4][2], const pg8::Unit& u, int wr, int wc, int fr, int fq) const {
    const float* mrow = modl + (size_t)4 * 9216 + gate * 1024;
#pragma unroll
    for (int ai = 0; ai < 2; ++ai)
#pragma unroll
      for (int m = 0; m < 4; ++m) {
        const int row = u.pm * 256 + ai * 128 + wr * 64 + m * 16 + fr;
#pragma unroll
        for (int bj = 0; bj < 2; ++bj)
#pragma unroll
          for (int n = 0; n < 2; ++n) {
            const int col = u.pn * 256 + bj * 128 + wc * 32 + n * 16 + 4 * fq;
            const f32x4 mv = *(const f32x4*)(mrow + col);
            f32x4 o;
#pragma unroll
            for (int j = 0; j < 4; ++j) o[j] = scale * mv[j] * acc[ai][bj][m][n][j];
            *(f32x4*)(P + (size_t)row * DM + col) = o;
          }
      }
  }
};
__device__ __forceinline__ void ffn_down_phase(const Params& p, const bf16_t* G, const bf16_t* W, const float* modl, int gate, bool from_input, bool with_ctx, char* smem) {
  gemm8(G, W, TL, DM, DFF, Epi8Res{p, modl, gate, 0.5f, from_input}, smem);
  if (with_ctx) {
    float* P = (float*)(WSP(p) + OFF_PART);
    gemm8(G + (size_t)TL * DFF, W, TC, DM, 1408, Epi8Part{P, modl, gate, 0.5f}, smem, DFF, 0);
    gemm8(G + (size_t)TL * DFF + 1408, W + 1408, TC, DM, 1408, Epi8Part{P + (size_t)TC * DM, modl, gate, 0.5f}, smem, DFF, 16);
  }
}
__device__ __forceinline__ void phase_mixprep(const Params& p, int layer) {
  bf16_t* U = (bf16_t*)(WSP(p) + OFF_BIG);
  const int ld = layer == 0 ? 3072 : 2560;
  const int qcol0 = layer == 0 ? 0 : 1024;
  const float* qg = layer == 0 ? PRM(p, na_q_g) : PRM(p, diff_q_g);
  const float* kg = layer == 0 ? PRM(p, na_k_g) : PRM(p, diff_k_g);
  const int gtid = blockIdx.x * NT + tidx(), gsz = gridDim.x * NT;
  for (int it = gtid; it < TT * 128; it += gsz) {
    const int row = it >> 7, e = it & 127, grp = e >> 3, sub = e & 7;
    bf16_t* ptr = U + (size_t)row * ld + qcol0 + grp * 64 + sub * 8;
    const u32x4 v = *(const u32x4*)ptr;
    float f[8] = {bflo(v.x), bfhi(v.x), bflo(v.y), bfhi(v.y), bflo(v.z), bfhi(v.z), bflo(v.w), bfhi(v.w)};
    float ss = 0.f;
#pragma unroll
    for (int j = 0; j < 8; ++j) ss += f[j] * f[j];
    ss += __shfl_xor(ss, 1); ss += __shfl_xor(ss, 2); ss += __shfl_xor(ss, 4);
    const float rstd = rsqrtf(ss * (1.f / 64.f) + EPS);
    const bool isq = grp < 8;
    const float* gp = (isq ? qg : kg) + sub * 8;
#pragma unroll
    for (int j = 0; j < 8; ++j) f[j] = f[j] * rstd * gp[j];
    if (layer == 1 && row < TL) {
      const int t = row & 8191, gr = t >> 6, gc = t & 63;
      const float* rt = (const float*)(WSP(p) + OFF_ROPE);
#pragma unroll
      for (int j = 0; j < 4; ++j) {
        const int i = sub * 4 + j;
        const int pos = i < 16 ? gr : 128 + gc;
        const f32x2_t csn = *(const f32x2_t*)(rt + (pos * 16 + (i & 15)) * 2);
        const float x1 = f[2 * j], x2 = f[2 * j + 1];
        f[2 * j] = x1 * csn[0] - x2 * csn[1]; f[2 * j + 1] = x1 * csn[1] + x2 * csn[0];
      }
    }
    if (isq) {
#pragma unroll
      for (int j = 0; j < 8; ++j) f[j] *= 0.125f * LOG2E;
    }
    u32x4 o = {cvtpk(f[0], f[1]), cvtpk(f[2], f[3]), cvtpk(f[4], f[5]), cvtpk(f[6], f[7])};
    *(u32x4*)ptr = o;
    if (layer == 0) {
      bf16_t* XBC = (bf16_t*)(WSP(p) + OFF_XBC);
      const int c0 = e * 8;
      int t, len;
      if (row < TL) { t = row & 8191; len = 8192; } else { t = (row - TL) & 255; len = 256; }
      float a[8];
#pragma unroll
      for (int j = 0; j < 8; ++j) a[j] = PRM(p, ssd_conv_b)[c0 + j];
#pragma unroll
      for (int k = 0; k < 4; ++k) {
        const int tt = t + k - 2;
        if (tt >= 0 && tt < len) {
          const u32x4 v = *(const u32x4*)(U + (size_t)(row + k - 2) * 3072 + 2048 + c0);
          const float* wk = PRM(p, ssd_conv_w) + k * 1024 + c0;
          a[0] += wk[0] * bflo(v.x); a[1] += wk[1] * bfhi(v.x); a[2] += wk[2] * bflo(v.y); a[3] += wk[3] * bfhi(v.y);
          a[4] += wk[4] * bflo(v.z); a[5] += wk[5] * bfhi(v.z); a[6] += wk[6] * bflo(v.w); a[7] += wk[7] * bfhi(v.w);
        }
      }
#pragma unroll
      for (int j = 0; j < 8; ++j) a[j] = siluf(a[j]);
      u32x4 oc = {cvtpk(a[0], a[1]), cvtpk(a[2], a[3]), cvtpk(a[4], a[5]), cvtpk(a[6], a[7])};
      *(u32x4*)(XBC + (size_t)row * 1024 + c0) = oc;
    }
  }
}


constexpr int NKEYS = 8448;
__device__ __forceinline__ void phase_vt(const Params& p, char* smem) {
  const bf16_t* U = (const bf16_t*)(WSP(p) + OFF_BIG);
  bf16_t* VT = (bf16_t*)(WSP(p) + OFF_XBC);
  const int tid = tidx();
  for (int u = blockIdx.x; u < 16 * 132; u += gridDim.x) {
    const int bh = u / 132, kt = u - bh * 132, b = bh >> 2, head = bh & 3;
    const int ktok = kt < 4 ? TL + b * 256 + kt * 64 : b * 8192 + (kt - 4) * 64;
    __syncthreads();
    stage_T<false>(U + (size_t)ktok * 2560 + 2048 + head * 128, 2560, 64, 128, smem, 136, nullptr);
    __syncthreads();
    for (int idx = tid; idx < 2048; idx += NT) {
      const int dv = idx >> 4, g = idx & 15, st = g >> 2, gi = g & 3, pos = st * 4 + ((gi & 1) * 2 + (gi >> 1));
      const u32x2 v = *(const u32x2*)(smem + dv * 136 + g * 8);
      *(u32x2*)(VT + ((size_t)(bh * 128 + dv)) * NKEYS + kt * 64 + pos * 4) = v;
    }
  }
  __syncthreads();
}
__device__ __forceinline__ void na_unit(const Params& p, int b, int qtok0, int hq, int grow, char* smem) {
  const int tid = tidx(), lane = tid & 63, w = tid >> 6, hl = w >> 1, half = w & 1, l31 = lane & 31, h = lane >> 5;
  const bf16_t* U = (const bf16_t*)(WSP(p) + OFF_BIG);
  bf16_t* H = (bf16_t*)(WSP(p) + OFF_H);
  char* Ks = smem;
  char* Vt = smem + 36864;
  float* rp = (float*)(smem + 36864 + 34816);
  const float Mb = ((const float*)(WSP(p) + OFF_SCAL))[0];
  const int head = hq * 4 + hl;
  const int qtok = qtok0 + half * 32 + l31;
  bf16x8 qf[4];
#pragma unroll
  for (int s = 0; s < 4; ++s) qf[s] = *(const bf16x8*)(U + (size_t)qtok * 3072 + head * 64 + s * 16 + h * 8);
  f32x16 o0, o1;
#pragma unroll
  for (int i = 0; i < 16; ++i) { o0[i] = 0.f; o1[i] = 0.f; }
  float lsum = 0.f;
  const bool lat = grow >= 0;
  int r0 = 0;
  if (lat) {
    r0 = min(max(grow - 4, 0), 120);
    for (int i = tid; i < 4 * 465; i += NT) rp[i] = PRM(p, na_rpb)[(size_t)hq * 4 * 465 + i] * LOG2E;
  }
  const int cq = half * 32 + l31;
  unsigned mbits = 0;
  {
    const int qc0 = min(max(cq - 8, 0), 48);
#pragma unroll
    for (int kb = 0; kb < 2; ++kb)
#pragma unroll
      for (int i = 0; i < 16; ++i) {
        const int kc = kb * 32 + (i & 3) + 8 * (i >> 2) + 4 * h;
        if (kc >= qc0 && kc < qc0 + 16) mbits |= 1u << (kb * 16 + i);
      }
  }
  const int boff = 4 * h - cq + 15;
  u32x4 rk[4]; u32x2 rv[2][4];
  auto gload = [&](int kt) {
    const int ktok0 = kt < 8 ? b * 8192 + (r0 + kt) * 64 : TL + b * 256 + (kt - 8) * 64;
#pragma unroll
    for (int i = 0; i < 4; ++i) {
      const int c = tid + i * NT, key = c >> 5, hh = (c >> 3) & 3, kc = c & 7;
      rk[i] = *(const u32x4*)(U + (size_t)(ktok0 + key) * 3072 + 512 + hq * 256 + hh * 64 + kc * 8);
    }
#pragma unroll
    for (int j = 0; j < 2; ++j) {
      const int m = tid + j * NT, tc = m & 63, tt = m >> 6;
      const bf16_t* sp = U + (size_t)(ktok0 + tt * 4) * 3072 + 1024 + hq * 256 + tc * 4;
      rv[j][0] = *(const u32x2*)sp; rv[j][1] = *(const u32x2*)(sp + 3072); rv[j][2] = *(const u32x2*)(sp + 2 * 3072); rv[j][3] = *(const u32x2*)(sp + 3 * 3072);
    }
  };
  auto lstore = [&]() {
#pragma unroll
    for (int i = 0; i < 4; ++i) {
      const int c = tid + i * NT, key = c >> 5, hh = (c >> 3) & 3, kc = c & 7;
      *(u32x4*)(Ks + hh * 9216 + key * 144 + kc * 16) = rk[i];
    }
#pragma unroll
    for (int j = 0; j < 2; ++j) {
      const int m = tid + j * NT, tc = m & 63, tt = m >> 6;
      const u32x2 v0 = rv[j][0], v1 = rv[j][1], v2 = rv[j][2], v3 = rv[j][3];
      u32x2 o0, o1, o2, o3;
      o0.x = (v0.x & 0xffffu) | (v1.x << 16); o0.y = (v2.x & 0xffffu) | (v3.x << 16);
      o1.x = (v0.x >> 16) | (v1.x & 0xffff0000u); o1.y = (v2.x >> 16) | (v3.x & 0xffff0000u);
      o2.x = (v0.y & 0xffffu) | (v1.y << 16); o2.y = (v2.y & 0xffffu) | (v3.y << 16);
      o3.x = (v0.y >> 16) | (v1.y & 0xffff0000u); o3.y = (v2.y >> 16) | (v3.y & 0xffff0000u);
      char* d = Vt + (size_t)(tc * 4) * 136 + tt * 8;
      *(u32x2*)d = o0; *(u32x2*)(d + 136) = o1; *(u32x2*)(d + 272) = o2; *(u32x2*)(d + 408) = o3;
    }
  };
  gload(lat ? 0 : 8);
  for (int kt = lat ? 0 : 8; kt < 12; ++kt) {
    __syncthreads();
    lstore();
    __syncthreads();
    if (kt + 1 < 12) gload(kt + 1);
    const int dr = r0 + kt - grow + 7;
    unsigned mb = mbits;
    asm volatile("" : "+v"(mb));
    const float* pb = rp + hl * 465 + dr * 31 + boff;
#pragma unroll
    for (int kb = 0; kb < 2; ++kb) {
      f32x16 s;
#pragma unroll
      for (int i = 0; i < 16; ++i) s[i] = -Mb;
#pragma unroll
      for (int sp = 0; sp < 4; ++sp) s = mfma32(ldsfrag16(Ks + hl * 9216 + (kb * 32 + l31) * 144 + sp * 32 + h * 16), qf[sp], s);
      float pv[16];
      if (kt < 8) {
#pragma unroll
        for (int i = 0; i < 16; ++i) {
          const float e = __builtin_amdgcn_exp2f(s[i] + pb[kb * 32 + (i & 3) + 8 * (i >> 2)]);
          pv[i] = __uint_as_float(__float_as_uint(e) & (unsigned)__builtin_amdgcn_sbfe((int)mb, kb * 16 + i, 1));
          lsum += pv[i];
        }
      } else {
#pragma unroll
        for (int i = 0; i < 16; ++i) { pv[i] = __builtin_amdgcn_exp2f(s[i]); lsum += pv[i]; }
      }
#pragma unroll
      for (int ss = 0; ss < 2; ++ss) {
        u32x4 pk = {cvtpk(pv[8 * ss], pv[8 * ss + 1]), cvtpk(pv[8 * ss + 2], pv[8 * ss + 3]), cvtpk(pv[8 * ss + 4], pv[8 * ss + 5]), cvtpk(pv[8 * ss + 6], pv[8 * ss + 7])};
        const bf16x8 pf = __builtin_bit_cast(bf16x8, pk);
        const char* vb = Vt + (size_t)(hl * 64 + l31) * 136 + (kb * 32 + ss * 16 + 4 * h) * 2;
        o0 = mfma32(ldsfrag8x2(vb, vb + 16), pf, o0);
        o1 = mfma32(ldsfrag8x2(vb + 32 * 136, vb + 32 * 136 + 16), pf, o1);
      }
    }
  }
  lsum += __shfl_xor(lsum, 32);
  float inv = 1.f / lsum;
#ifdef NA_ZERO
  inv = 0.f * (lsum > 0.f ? 1.f : 0.f); for (int i = 0; i < 16; ++i) { o0[i] = 1.f; o1[i] = 1.f; }
#endif
  bf16_t* hp = H + (size_t)qtok * DM + head * 64;
#pragma unroll
  for (int g = 0; g < 4; ++g) {
    u32x2 a = {cvtpk(o0[4 * g] * inv, o0[4 * g + 1] * inv), cvtpk(o0[4 * g + 2] * inv, o0[4 * g + 3] * inv)};
    u32x2 c = {cvtpk(o1[4 * g] * inv, o1[4 * g + 1] * inv), cvtpk(o1[4 * g + 2] * inv, o1[4 * g + 3] * inv)};
    *(u32x2*)(hp + 8 * g + 4 * h) = a;
    *(u32x2*)(hp + 32 + 8 * g + 4 * h) = c;
  }
  __syncthreads();
}

__device__ __forceinline__ void wave_cumsum2(float v0, float v1, float& c0, float& c1, float& tot, int lane) {
  float s = v0 + v1;
#pragma unroll
  for (int o = 1; o < 64; o <<= 1) { const float t = __shfl_up(s, o); if (lane >= o) s += t; }
  c1 = s; c0 = s - v1; tot = __int_as_float(__builtin_amdgcn_readlane(__float_as_int(s), 63));
}
__device__ __forceinline__ void ssdA_unit(const Params& p, int b, int cc, int head, char* smem) {
  const int tid = tidx(), lane = tid & 63, w = tid >> 6, l31 = lane & 31, h = lane >> 5;
  const int tok0 = chunk_tok0(b, cc), g = head >> 2;
  const bf16_t* XBC = (const bf16_t*)(WSP(p) + OFF_XBC);
  const float* DT = (const float*)(WSP(p) + OFF_DT);
  char* BT = smem;
  char* XWT = smem + 34816;
  float* wl = (float*)(smem + 69632);
  if (w < 2) {
    const int dir = w;
    const float d0 = DT[(size_t)(tok0 + 2 * lane) * 16 + dir * 8 + head], d1 = DT[(size_t)(tok0 + 2 * lane + 1) * 16 + dir * 8 + head];
    const float Aa = -expf(PRM(p, ssd_a_log)[dir * 8 + head]);
    const float v0 = d0 * Aa, v1 = d1 * Aa;
    float c0, c1, tot;
    wave_cumsum2(v0, v1, c0, c1, tot, lane);
    if (dir == 0) { wl[2 * lane] = expf(tot - c0) * d0; wl[2 * lane + 1] = expf(tot - c1) * d1; }
    else { wl[128 + 2 * lane] = expf(c0 - v0) * d0; wl[128 + 2 * lane + 1] = expf(c1 - v1) * d1; }
    if (lane == 0) ((float*)(WSP(p) + OFF_DEC))[((b * 2 + dir) * 8 + head) * 66 + cc] = expf(tot);
  }
  __syncthreads();
  stage_T<false>(XBC + (size_t)tok0 * 1024 + 512 + g * 128, 1024, 128, 128, BT, 272, nullptr);
  stage_T<true>(XBC + (size_t)tok0 * 1024 + head * 64, 1024, 128, 64, XWT, 272, wl);
  stage_T<true>(XBC + (size_t)tok0 * 1024 + head * 64, 1024, 128, 64, XWT + 17408, 272, wl + 128);
  __syncthreads();
  {
    const int dir = w >> 2, nb = w & 3;
    f32x16 a0, a1;
#pragma unroll
    for (int i = 0; i < 16; ++i) { a0[i] = 0.f; a1[i] = 0.f; }
    const char* xb = XWT + dir * 17408;
#pragma unroll
    for (int ks = 0; ks < 8; ++ks) {
      const bf16x8 bt = ldsfrag16(BT + (nb * 32 + l31) * 272 + ks * 32 + h * 16);
      a0 = mfma32(bt, ldsfrag16(xb + l31 * 272 + ks * 32 + h * 16), a0);
      a1 = mfma32(bt, ldsfrag16(xb + (32 + l31) * 272 + ks * 32 + h * 16), a1);
    }
    bf16_t* st = (bf16_t*)(WSP(p) + OFF_ST) + ((size_t)(((b * 2 + dir) * 8 + head) * 66 + cc)) * 8192;
#pragma unroll
    for (int gg = 0; gg < 4; ++gg) {
      const int n = nb * 32 + 8 * gg + 4 * h;
      u32x2 x0 = {cvtpk(a0[4 * gg], a0[4 * gg + 1]), cvtpk(a0[4 * gg + 2], a0[4 * gg + 3])};
      u32x2 x1 = {cvtpk(a1[4 * gg], a1[4 * gg + 1]), cvtpk(a1[4 * gg + 2], a1[4 * gg + 3])};
      *(u32x2*)(st + (size_t)l31 * 128 + n) = x0;
      *(u32x2*)(st + (size_t)(32 + l31) * 128 + n) = x1;
    }
  }
  __syncthreads();
}
__device__ __forceinline__ int scan_order(int dir, int s) { return dir == 0 ? s : (s == 0 ? 1 : (s == 1 ? 0 : 67 - s)); }
__device__ __forceinline__ void phase_ssdB(const Params& p) {
  const int gtid = blockIdx.x * NT + tidx(), gsz = gridDim.x * NT;
  bf16_t* ST = (bf16_t*)(WSP(p) + OFF_ST);
  const float* DEC = (const float*)(WSP(p) + OFF_DEC);
  for (int item = gtid; item < 64 * 2048; item += gsz) {
    const int combo = item >> 11, e = (item & 2047) * 4;
    const int dir = (combo >> 3) & 1;
    bf16_t* base = ST + (size_t)combo * 66 * 8192 + e;
    const float* dec = DEC + combo * 66;
    float h0 = 0.f, h1 = 0.f, h2 = 0.f, h3 = 0.f;
    for (int s0 = 0; s0 < 66; s0 += 11) {
      u32x2 v[11]; float d[11];
#pragma unroll
      for (int q = 0; q < 11; ++q) { const int cc = scan_order(dir, s0 + q); v[q] = *(const u32x2*)(base + (size_t)cc * 8192); d[q] = dec[cc]; }
#pragma unroll
      for (int q = 0; q < 11; ++q) {
        const int cc = scan_order(dir, s0 + q);
        u32x2 o = {cvtpk(h0, h1), cvtpk(h2, h3)};
        *(u32x2*)(base + (size_t)cc * 8192) = o;
        h0 = h0 * d[q] + bflo(v[q].x); h1 = h1 * d[q] + bfhi(v[q].x); h2 = h2 * d[q] + bflo(v[q].y); h3 = h3 * d[q] + bfhi(v[q].y);
      }
    }
  }
}
__device__ __forceinline__ void ssdC_unit(const Params& p, int b, int cc, int head, char* smem) {
  const int tid = tidx(), lane = tid & 63, w = tid >> 6, l31 = lane & 31, h = lane >> 5;
  const int tok0 = chunk_tok0(b, cc), g = head >> 2;
  const bf16_t* XBC = (const bf16_t*)(WSP(p) + OFF_XBC);
  const bf16_t* U = (const bf16_t*)(WSP(p) + OFF_BIG);
  const float* DT = (const float*)(WSP(p) + OFF_DT);
  bf16_t* H = (bf16_t*)(WSP(p) + OFF_H);
  char* Cn = smem;
  char* Bn = smem + 34816;
  char* XT = smem + 69632;
  char* Hf = smem + 87040;
  char* Hb = smem + 104448;
  float* vec = (float*)(smem + 121856);
  if (w < 2) {
    const int dir = w;
    const float d0 = DT[(size_t)(tok0 + 2 * lane) * 16 + dir * 8 + head], d1 = DT[(size_t)(tok0 + 2 * lane + 1) * 16 + dir * 8 + head];
    const float Aa = -expf(PRM(p, ssd_a_log)[dir * 8 + head]);
    const float v0 = d0 * Aa, v1 = d1 * Aa;
    float c0, c1, tot;
    wave_cumsum2(v0, v1, c0, c1, tot, lane);
    if (dir == 0) {
      vec[2 * lane] = c0; vec[2 * lane + 1] = c1; vec[256 + 2 * lane] = d0; vec[256 + 2 * lane + 1] = d1;
      vec[512 + 2 * lane] = expf(c0); vec[512 + 2 * lane + 1] = expf(c1);
    } else {
      vec[128 + 2 * lane] = c0 - v0; vec[128 + 2 * lane + 1] = c1 - v1; vec[384 + 2 * lane] = d0; vec[384 + 2 * lane + 1] = d1;
      vec[640 + 2 * lane] = expf(tot - (c0 - v0)); vec[640 + 2 * lane + 1] = expf(tot - (c1 - v1));
    }
  }
  stage_N(XBC + (size_t)tok0 * 1024 + 768 + g * 128, 1024, 128, 256, Cn, 272);
  stage_N(XBC + (size_t)tok0 * 1024 + 512 + g * 128, 1024, 128, 256, Bn, 272);
  stage_T<false>(XBC + (size_t)tok0 * 1024 + head * 64, 1024, 128, 64, XT, 272, nullptr);
  const bf16_t* ST = (const bf16_t*)(WSP(p) + OFF_ST);
  stage_N(ST + ((size_t)(((b * 2 + 0) * 8 + head) * 66 + cc)) * 8192, 128, 64, 256, Hf, 272);
  stage_N(ST + ((size_t)(((b * 2 + 1) * 8 + head) * 66 + cc)) * 8192, 128, 64, 256, Hb, 272);
  __syncthreads();
  const float* csf = vec; const float* exb = vec + 128; const float* dtf = vec + 256; const float* dtb = vec + 384;
  const float* ef = vec + 512; const float* eb = vec + 640;
  {
    const int ib = w & 3, jb0 = (w >> 2) * 2;
    f32x16 c0, c1;
#pragma unroll
    for (int i = 0; i < 16; ++i) { c0[i] = 0.f; c1[i] = 0.f; }
#pragma unroll
    for (int ks = 0; ks < 8; ++ks) {
      const bf16x8 cf = ldsfrag16(Cn + (ib * 32 + l31) * 272 + ks * 32 + h * 16);
      c0 = mfma32(ldsfrag16(Bn + (jb0 * 32 + l31) * 272 + ks * 32 + h * 16), cf, c0);
      c1 = mfma32(ldsfrag16(Bn + ((jb0 + 1) * 32 + l31) * 272 + ks * 32 + h * 16), cf, c1);
    }
    __syncthreads();
    const int i = ib * 32 + l31;
    const float csi = csf[i], exi = exb[i];
#pragma unroll
    for (int jj = 0; jj < 2; ++jj) {
#pragma unroll
      for (int gg = 0; gg < 4; ++gg) {
        const int j0 = (jb0 + jj) * 32 + 8 * gg + 4 * h;
        float m[4];
#pragma unroll
        for (int x = 0; x < 4; ++x) {
          const int j = j0 + x;
          const float cb = jj == 0 ? c0[4 * gg + x] : c1[4 * gg + x];
          float fv = 0.f;
          if (j <= i) fv += __expf(csi - csf[j]) * dtf[j];
          if (j >= i) fv += __expf(exb[j] - exi) * dtb[j];
          m[x] = cb * fv;
        }
        u32x2 o = {cvtpk(m[0], m[1]), cvtpk(m[2], m[3])};
        *(u32x2*)(Bn + i * 272 + j0 * 2) = o;
      }
    }
  }
  __syncthreads();
  {
    const int pb = w >> 2, ib = w & 3;
    f32x16 yd, yf, yb;
#pragma unroll
    for (int i = 0; i < 16; ++i) { yd[i] = 0.f; yf[i] = 0.f; yb[i] = 0.f; }
#pragma unroll
    for (int ks = 0; ks < 8; ++ks) {
      yd = mfma32(ldsfrag16(XT + (pb * 32 + l31) * 272 + ks * 32 + h * 16), ldsfrag16(Bn + (ib * 32 + l31) * 272 + ks * 32 + h * 16), yd);
      const bf16x8 cf = ldsfrag16(Cn + (ib * 32 + l31) * 272 + ks * 32 + h * 16);
      yf = mfma32(ldsfrag16(Hf + (pb * 32 + l31) * 272 + ks * 32 + h * 16), cf, yf);
      yb = mfma32(ldsfrag16(Hb + (pb * 32 + l31) * 272 + ks * 32 + h * 16), cf, yb);
    }
    const int i = ib * 32 + l31, tok = tok0 + i;
    const float e_f = ef[i], e_b = eb[i], Dk = PRM(p, ssd_d)[head];
    float ssq = 0.f;
#pragma unroll
    for (int gg = 0; gg < 4; ++gg) {
      const int p0 = pb * 32 + 8 * gg + 4 * h;
      const u32x2 xv = *(const u32x2*)(XBC + (size_t)tok * 1024 + head * 64 + p0);
      const u32x2 zv = *(const u32x2*)(U + (size_t)tok * 3072 + 1536 + head * 64 + p0);
      const float xs[4] = {bflo(xv.x), bfhi(xv.x), bflo(xv.y), bfhi(xv.y)};
      const float zs[4] = {bflo(zv.x), bfhi(zv.x), bflo(zv.y), bfhi(zv.y)};
      float gv[4];
#pragma unroll
      for (int x = 0; x < 4; ++x) {
        const float y = yd[4 * gg + x] + e_f * yf[4 * gg + x] + e_b * yb[4 * gg + x] + Dk * xs[x];
        gv[x] = y * siluf(zs[x]);
        ssq += gv[x] * gv[x];
      }
      u32x2 o = {cvtpk(gv[0], gv[1]), cvtpk(gv[2], gv[3])};
      *(u32x2*)(H + (size_t)tok * DM + 512 + head * 64 + p0) = o;
    }
    ssq += __shfl_xor(ssq, 32);
    if (h == 0) ((float*)(WSP(p) + OFF_SSQ))[(size_t)tok * 16 + head * 2 + pb] = ssq;
  }
  __syncthreads();
}

__device__ __forceinline__ void lru_unit(const Params& p, int b, int cc, int nb, int mode, char* smem) {
  const int tid = tidx(), lane = tid & 63, w = tid >> 6, l31 = lane & 31, h = lane >> 5;
  const int tok0 = chunk_tok0(b, cc);
  const bf16_t* U = (const bf16_t*)(WSP(p) + OFF_BIG);
  float* xf = (float*)smem;
  float* aL = (float*)(smem + 34816);
  bf16_t* bL = (bf16_t*)(smem + 100352);
  float* segA = (float*)(smem + 133120);
  float* segH = segA + 1024;
  float* segS = segH + 1024;
  const int c = tid & 63, seg = tid >> 6;
  float gt[16];
  if (mode == 1) {
#pragma unroll
    for (int k = 0; k < 16; ++k) gt[k] = bflo((unsigned)U[(size_t)(tok0 + seg * 16 + k) * 2560 + nb * 64 + c]);
  }
  {
    const int t = tid >> 2, c0 = (tid & 3) * 16;
    int tseq, len;
    if (cc < 2) { tseq = cc * 128 + t; len = 256; } else { tseq = (cc - 2) * 128 + t; len = 8192; }
    float a[16];
#pragma unroll
    for (int jx = 0; jx < 16; ++jx) a[jx] = PRM(p, lru_conv_b)[nb * 64 + c0 + jx];
#pragma unroll
    for (int k = 0; k < 4; ++k) {
      const int ts = tseq + k - 2;
      if (ts >= 0 && ts < len) {
        const bf16_t* sp = U + (size_t)(tok0 + t + k - 2) * 2560 + 512 + nb * 64 + c0;
        const u32x4 v0 = *(const u32x4*)sp, v1 = *(const u32x4*)(sp + 8);
        const float* wk = PRM(p, lru_conv_w) + k * 512 + nb * 64 + c0;
        a[0] += wk[0] * bflo(v0.x); a[1] += wk[1] * bfhi(v0.x); a[2] += wk[2] * bflo(v0.y); a[3] += wk[3] * bfhi(v0.y);
        a[4] += wk[4] * bflo(v0.z); a[5] += wk[5] * bfhi(v0.z); a[6] += wk[6] * bflo(v0.w); a[7] += wk[7] * bfhi(v0.w);
        a[8] += wk[8] * bflo(v1.x); a[9] += wk[9] * bfhi(v1.x); a[10] += wk[10] * bflo(v1.y); a[11] += wk[11] * bfhi(v1.y);
        a[12] += wk[12] * bflo(v1.z); a[13] += wk[13] * bfhi(v1.z); a[14] += wk[14] * bflo(v1.w); a[15] += wk[15] * bfhi(v1.w);
      }
    }
#pragma unroll
    for (int jx = 0; jx < 16; ++jx) xf[t * 68 + c0 + jx] = a[jx];
  }
  __syncthreads();
  const bf16_t* WL = (const bf16_t*)(WSP(p) + OFF_WLRU);
  {
    const int tb = w >> 1, eb = w & 1, e = eb * 32 + l31, ch = nb * 64 + e;
    bf16x8 xa[4];
#pragma unroll
    for (int s4 = 0; s4 < 4; ++s4) {
      const float* xp = xf + (tb * 32 + l31) * 68 + s4 * 16 + h * 8;
      const f32x4 x0 = *(const f32x4*)xp, x1 = *(const f32x4*)(xp + 4);
      u32x4 pk = {cvtpk(x0[0], x0[1]), cvtpk(x0[2], x0[3]), cvtpk(x1[0], x1[1]), cvtpk(x1[2], x1[3])};
      xa[s4] = __builtin_bit_cast(bf16x8, pk);
    }
#pragma unroll 1
    for (int dir = 0; dir < 2; ++dir) {
      f32x16 ra, ia;
#pragma unroll
      for (int i = 0; i < 16; ++i) { ra[i] = 0.f; ia[i] = 0.f; }
      const bf16_t* wa = WL + ((size_t)((0 * 2 + dir) * 8 + nb)) * 4096 + e * 64;
      const bf16_t* wx = WL + ((size_t)((1 * 2 + dir) * 8 + nb)) * 4096 + e * 64;
#pragma unroll
      for (int s4 = 0; s4 < 4; ++s4) {
        ra = mfma32(xa[s4], *(const bf16x8*)(wa + s4 * 16 + h * 8), ra);
        ia = mfma32(xa[s4], *(const bf16x8*)(wx + s4 * 16 + h * 8), ia);
      }
      const float ba = PRM(p, lru_ba)[dir * 512 + ch], bx = PRM(p, lru_bx)[dir * 512 + ch];
      const float sp = softplusf(-PRM(p, lru_lambda)[dir * 512 + ch]);
#pragma unroll
      for (int i = 0; i < 16; ++i) {
        const int t = tb * 32 + (i & 3) + 8 * (i >> 2) + 4 * h;
        const float rg = sigmf(ra[i] + ba), ig = sigmf(ia[i] + bx);
        const float la = -8.f * rg * sp;
        const float av = __expf(la);
        const float bv = __builtin_amdgcn_sqrtf(fmaxf(1.f - av * av, 0.f)) * ig * xf[t * 68 + e];
        aL[(dir * 128 + t) * 64 + e] = av;
        bL[(dir * 128 + t) * 64 + e] = (bf16_t)(cvtpk(bv, 0.f) & 0xffffu);
      }
    }
  }
  __syncthreads();
  {
    float A0 = 1.f, H0 = 0.f, A1 = 1.f, H1 = 0.f;
#pragma unroll
    for (int k = 0; k < 16; ++k) {
      const int t0 = seg * 16 + k, t1 = seg * 16 + 15 - k;
      const float a0 = aL[t0 * 64 + c], a1 = aL[(128 + t1) * 64 + c];
      H0 = a0 * H0 + bflo((unsigned)bL[t0 * 64 + c]); A0 *= a0;
      H1 = a1 * H1 + bflo((unsigned)bL[(128 + t1) * 64 + c]); A1 *= a1;
    }
    segA[seg * 64 + c] = A0; segH[seg * 64 + c] = H0;
    segA[512 + seg * 64 + c] = A1; segH[512 + seg * 64 + c] = H1;
  }
  __syncthreads();
  if (tid < 128) {
    const int dir = tid >> 6;
    const size_t cidx = ((size_t)((b * 2 + dir) * 66 + cc)) * 512 + nb * 64 + c;
    if (mode == 0) {
      float At = 1.f, Ht = 0.f;
#pragma unroll
      for (int q = 0; q < 8; ++q) { const int sg = dir == 0 ? q : 7 - q; Ht = segA[dir * 512 + sg * 64 + c] * Ht + segH[dir * 512 + sg * 64 + c]; At *= segA[dir * 512 + sg * 64 + c]; }
      ((float*)(WSP(p) + OFF_LCA))[cidx] = At; ((float*)(WSP(p) + OFF_LCH))[cidx] = Ht;
    } else {
      float hcur = ((const float*)(WSP(p) + OFF_LHIN))[cidx];
#pragma unroll
      for (int q = 0; q < 8; ++q) { const int sg = dir == 0 ? q : 7 - q; segS[dir * 512 + sg * 64 + c] = hcur; hcur = segA[dir * 512 + sg * 64 + c] * hcur + segH[dir * 512 + sg * 64 + c]; }
    }
  }
  if (mode == 1) {
    __syncthreads();
    float hf[16];
    float hc = segS[seg * 64 + c];
#pragma unroll
    for (int k = 0; k < 16; ++k) { const int t = seg * 16 + k; hc = aL[t * 64 + c] * hc + bflo((unsigned)bL[t * 64 + c]); hf[k] = hc; }
    hc = segS[512 + seg * 64 + c];
    bf16_t* hp = (bf16_t*)(WSP(p) + OFF_H) + (size_t)(tok0 + seg * 16) * DM + nb * 64 + c;
#pragma unroll
    for (int k = 15; k >= 0; --k) {
      const int t = seg * 16 + k;
      hc = aL[(128 + t) * 64 + c] * hc + bflo((unsigned)bL[(128 + t) * 64 + c]);
      hp[(size_t)k * DM] = (bf16_t)(cvtpk(gelu_tanh(gt[k]) * (hf[k] + hc), 0.f) & 0xffffu);
    }
  }
  __syncthreads();
}
__device__ __forceinline__ void phase_lruY(const Params& p) {
  const int gtid = blockIdx.x * NT + tidx();
  if (gtid < 4096) {
    const int ch = gtid & 511, bd = gtid >> 9, dir = bd & 1;
    const float* CA = (const float*)(WSP(p) + OFF_LCA) + (size_t)bd * 66 * 512 + ch;
    const float* CH = (const float*)(WSP(p) + OFF_LCH) + (size_t)bd * 66 * 512 + ch;
    float* HIN = (float*)(WSP(p) + OFF_LHIN) + (size_t)bd * 66 * 512 + ch;
    float hcur = 0.f;
    for (int s0 = 0; s0 < 66; s0 += 11) {
      float a[11], hh[11];
#pragma unroll
      for (int q = 0; q < 11; ++q) { const int cc = scan_order(dir, s0 + q); a[q] = CA[cc * 512]; hh[q] = CH[cc * 512]; }
#pragma unroll
      for (int q = 0; q < 11; ++q) { const int cc = scan_order(dir, s0 + q); HIN[cc * 512] = hcur; hcur = a[q] * hcur + hh[q]; }
    }
  }
}

__device__ __forceinline__ void diff_unit(const Params& p, int b, int head, int qb, char* smem) {
  const int tid = tidx(), lane = tid & 63, w = __builtin_amdgcn_readfirstlane(tid >> 6), l31 = lane & 31, h = lane >> 5, grp = w >> 1, t = w & 1;
  const bf16_t* U = (const bf16_t*)(WSP(p) + OFF_BIG);
  const bf16_t* VT = (const bf16_t*)(WSP(p) + OFF_XBC) + (size_t)((b * 4 + head) * 128) * NKEYS;
  const float* sc = (const float*)(WSP(p) + OFF_SCAL);
  const float Mb = sc[1], lam = sc[2];
  const int qtok = b * 8192 + qb * 256 + grp * 64 + l31;
  char* Qs = smem;
  char* stg = smem + 69632;
  stage_N(U + (size_t)(b * 8192 + qb * 256) * 2560 + 1024 + head * 128, 2560, 256, 256, Qs, 272);
  const char* qrow = Qs + (grp * 64 + l31) * 272 + t * 128 + h * 16;
  f32x16 o[2][4];
#pragma unroll
  for (int qg = 0; qg < 2; ++qg)
#pragma unroll
    for (int d = 0; d < 4; ++d)
#pragma unroll
      for (int i = 0; i < 16; ++i) o[qg][d][i] = 0.f;
  float l0 = 0.f, l1 = 0.f;
  auto dma = [&](int kt, int buf) {
    const int ktk = kt < 4 ? TL + b * 256 + kt * 64 : b * 8192 + (kt - 4) * 64;
    const bf16_t* kb_ = U + (size_t)ktk * 2560;
    const bf16_t* vb_ = VT + kt * 64;
    char* Ks = stg + buf * 32768;
#pragma unroll
    for (int jx = 0; jx < 2; ++jx) {
      int tl = tid; asm volatile("" : "+v"(tl));
      const int L = jx * 512 + tl, key = L >> 4, c = (L & 15) ^ (key & 15);
      const unsigned koffj = (unsigned)(key * 2560 + 1536 + head * 128 + c * 8);
      const int dvv = L >> 3, cv = (L & 7) ^ ((dvv >> 1) & 7);
      const unsigned voffj = (unsigned)(dvv * NKEYS + cv * 8);
      __builtin_amdgcn_global_load_lds((const unsigned*)(kb_ + koffj), (PG8_LAS unsigned*)(Ks + (jx * 512 + w * 64) * 16), 16, 0, 0);
      __builtin_amdgcn_global_load_lds((const unsigned*)(vb_ + voffj), (PG8_LAS unsigned*)(Ks + 16384 + (jx * 512 + w * 64) * 16), 16, 0, 0);
    }
  };
  constexpr int NKT = 132;
  dma(0, 0);
  asm volatile("s_waitcnt vmcnt(0)" ::: "memory");
  __syncthreads();
  for (int kt = 0; kt < NKT; ++kt) {
    if (kt + 1 < NKT) dma(kt + 1, (kt + 1) & 1);
    const char* Ks = stg + (kt & 1) * 32768; const char* Vt = Ks + 16384;
#pragma unroll 1
    for (int kb = 0; kb < 2; ++kb) {
      f32x16 s0, s1;
#pragma unroll
      for (int i = 0; i < 16; ++i) { s0[i] = -Mb; s1[i] = -Mb; }
      const int key = kb * 32 + l31;
      __builtin_amdgcn_s_setprio(1);
#pragma unroll
      for (int sp = 0; sp < 4; ++sp) {
        const bf16x8 kf = ldsfrag16(Ks + key * 256 + (((t * 8 + sp * 2 + h) ^ (key & 15)) << 4));
        s0 = mfma32(kf, ldsfrag16(qrow + sp * 32), s0);
        s1 = mfma32(kf, ldsfrag16(qrow + 32 * 272 + sp * 32), s1);
      }
      __builtin_amdgcn_s_setprio(0);
      bf16x8 pf0[2], pf1[2];
#pragma unroll
      for (int i = 0; i < 16; ++i) { s0[i] = __builtin_amdgcn_exp2f(s0[i]); l0 += s0[i]; }
#pragma unroll
      for (int ss = 0; ss < 2; ++ss) {
        u32x4 pk = {cvtpk(s0[8 * ss], s0[8 * ss + 1]), cvtpk(s0[8 * ss + 2], s0[8 * ss + 3]), cvtpk(s0[8 * ss + 4], s0[8 * ss + 5]), cvtpk(s0[8 * ss + 6], s0[8 * ss + 7])};
        pf0[ss] = __builtin_bit_cast(bf16x8, pk);
      }
#pragma unroll
      for (int i = 0; i < 16; ++i) { s1[i] = __builtin_amdgcn_exp2f(s1[i]); l1 += s1[i]; }
#pragma unroll
      for (int ss = 0; ss < 2; ++ss) {
        u32x4 pk = {cvtpk(s1[8 * ss], s1[8 * ss + 1]), cvtpk(s1[8 * ss + 2], s1[8 * ss + 3]), cvtpk(s1[8 * ss + 4], s1[8 * ss + 5]), cvtpk(s1[8 * ss + 6], s1[8 * ss + 7])};
        pf1[ss] = __builtin_bit_cast(bf16x8, pk);
      }
      __builtin_amdgcn_sched_barrier(0);
      __builtin_amdgcn_s_setprio(1);
#pragma unroll
      for (int ss = 0; ss < 2; ++ss) {
#pragma unroll
        for (int d = 0; d < 4; ++d) {
          const int dv = d * 32 + l31;
          const bf16x8 vf = ldsfrag16(Vt + dv * 128 + ((((kb * 2 + ss) * 2 + h) ^ ((dv >> 1) & 7)) << 4));
          o[0][d] = mfma32(vf, pf0[ss], o[0][d]);
          o[1][d] = mfma32(vf, pf1[ss], o[1][d]);
        }
        __builtin_amdgcn_sched_barrier(0);
      }
      __builtin_amdgcn_s_setprio(0);
    }
    asm volatile("s_waitcnt vmcnt(0)" ::: "memory");
    __syncthreads();
  }
  l0 += __shfl_xor(l0, 32); l1 += __shfl_xor(l1, 32);
  float* ex = (float*)smem;
  if (t == 1) {
    const float c0 = lam / l0, c1 = lam / l1;
#pragma unroll
    for (int qg = 0; qg < 2; ++qg)
#pragma unroll
      for (int d = 0; d < 4; ++d) {
#pragma unroll
        for (int i = 0; i < 16; ++i) ex[(((grp * 2 + qg) * 4 + d) * 16 + i) * 64 + lane] = o[qg][d][i] * (qg == 0 ? c0 : c1);
        __builtin_amdgcn_sched_barrier(0);
      }
  }
  __syncthreads();
  if (t == 0) {
    const float* sgp = PRM(p, diff_subln_g);
#pragma unroll
    for (int qg = 0; qg < 2; ++qg) {
      const float i0 = 1.f / (qg == 0 ? l0 : l1);
      float ssq = 0.f;
#pragma unroll
      for (int d = 0; d < 4; ++d) {
#pragma unroll
        for (int i = 0; i < 16; ++i) { const float v = o[qg][d][i] * i0 - ex[(((grp * 2 + qg) * 4 + d) * 16 + i) * 64 + lane]; o[qg][d][i] = v; ssq += v * v; }
        __builtin_amdgcn_sched_barrier(0);
      }
      ssq += __shfl_xor(ssq, 32);
      const float rstd = rsqrtf(ssq * (1.f / 128.f) + EPS) * (1.f - LAM_INIT);
      bf16_t* hp = (bf16_t*)(WSP(p) + OFF_H) + (size_t)(qtok + qg * 32) * DM + 512 + head * 128;
#pragma unroll
      for (int d = 0; d < 4; ++d)
#pragma unroll
        for (int g = 0; g < 4; ++g) {
          const int dv = d * 32 + 8 * g + 4 * h;
          const f32x4 sg = *(const f32x4*)(sgp + dv);
          u32x2 ov = {cvtpk(o[qg][d][4 * g] * rstd * sg[0], o[qg][d][4 * g + 1] * rstd * sg[1]), cvtpk(o[qg][d][4 * g + 2] * rstd * sg[2], o[qg][d][4 * g + 3] * rstd * sg[3])};
          *(u32x2*)(hp + dv) = ov;
          __builtin_amdgcn_sched_barrier(0);
        }
    }
  }
  __syncthreads();
}

constexpr int NPHASE = 28;
#ifndef PHMASK
#define PHMASK 0xffff
#endif
#define EN(k) (((PHMASK) >> (k)) & 1)
__device__ __forceinline__ void grid_barrier(unsigned* bar, unsigned epoch);
__device__ __forceinline__ void run_phase(const Params& p, int ph, char* smem, unsigned* bar, unsigned& nbar, bool rep) {
  bf16_t* H = (bf16_t*)(WSP(p) + OFF_H);
  bf16_t* BIG = (bf16_t*)(WSP(p) + OFF_BIG);
  if (ph == 0) { if (EN(0)) phase_prep(p, smem, rep ? PROBE_SUB : 0); return; }
  if (ph == 1) {
    { const int gt = blockIdx.x * NT + tidx(); float* xc = (float*)(WSP(p) + OFF_XC); const float* cin = PRM(p, ctx);
      for (int i = gt; i < TC * DM / 4; i += gridDim.x * NT) *(f32x4*)(xc + (size_t)i * 4) = *(const f32x4*)(cin + (size_t)i * 4); }
    phase_modreduce(p); convert_weights(p, smem, 1, (int)blockIdx.x * 8 + (tidx() >> 6), (int)gridDim.x * 8); return;
  }
  const int layer = (ph - 2) / 13, s = (ph - 2) % 13;
  const float* modl = (const float*)(WSP(p) + OFF_MOD) + (size_t)layer * 5 * 9216;
  const bool last = layer == 1;
  switch (s) {
    case 0: if (EN(1)) phase_modnorm(p, layer, 0, layer == 0, TT, layer == 1); break;
    case 1:
      if (EN(2)) {
        const bf16_t* W = (const bf16_t*)(WSP(p) + OFF_W13) + (size_t)(layer * 2 + 0) * 5632 * DM;
        gemm8(H, W, TL, 5632, DM, Epi8Up{BIG}, smem);
        gemm_phase(H + (size_t)TL * DM, DM, W, DM, TC, 5632, 0, nullptr, EpiUp{BIG + (size_t)TL * DFF}, smem);
      }
      break;
    case 2:
      if (EN(3)) ffn_down_phase(p, BIG, (const bf16_t*)(WSP(p) + OFF_W2) + (size_t)(layer * 2 + 0) * DM * DFF, modl, 2, layer == 0, true, smem);
      break;
    case 3: if (EN(1)) phase_modnorm(p, layer, 1, false, TT, true); break;
    case 4:
      if (!EN(4)) break;
      if (!last) gemm8(H, (const bf16_t*)(WSP(p) + OFF_WABIN), TT, 3328, DM, Epi8InAB{BIG, (float*)(WSP(p) + OFF_DT), PRM(p, ssd_dt_bias)}, smem);
      else gemm8(H, (const bf16_t*)(WSP(p) + OFF_WCDIN), TT, 2560, DM, Epi8Bf{BIG, 2560}, smem);
      break;
    case 5: if (EN(5)) { phase_mixprep(p, layer); if (last) phase_vt(p, smem); } break;
    case 6:
      if (!last) {
        for (int u = blockIdx.x; u < 2112 + 1024 + 32; u += gridDim.x) {
          if (u < 2112) { const int head = u & 7, bc = u >> 3; if (EN(6)) ssdA_unit(p, bc / 66, bc % 66, head, smem); }
          else if (u < 3136) {
            const int v = u - 2112;
            int hq = v & 1, br = v >> 1;
            if ((gridDim.x & 7) == 0) { const int x = v & 7, jx = v >> 3; hq = x & 1; br = (x >> 1) * 128 + jx; }
            if (EN(7)) na_unit(p, br >> 7, (br >> 7) * 8192 + (br & 127) * 64, hq, br & 127, smem);
          }
          else { const int v = u - 3136, hq = v & 1, qb = (v >> 1) & 3, b = v >> 3; if (EN(7)) na_unit(p, b, TL + b * 256 + qb * 64, hq, -1, smem); }
        }
      } else {
        for (int u = blockIdx.x; u < 2112; u += gridDim.x) { const int nb = u & 7, bc = u >> 3; if (EN(8)) lru_unit(p, bc / 66, bc % 66, nb, 0, smem); }
      }
      break;
    case 7: if (EN(9)) { if (!last) phase_ssdB(p); else phase_lruY(p); } break;
    case 8:
      if (!last) {
        for (int u = blockIdx.x; u < 2112; u += gridDim.x) { const int head = u & 7, bc = u >> 3; if (EN(10)) ssdC_unit(p, bc / 66, bc % 66, head, smem); }
      } else {
        for (int u = blockIdx.x; u < 512 + 2048; u += gridDim.x) {
          if (u < 512) {
            int pair = u >> 5, qb = u & 31;
            if ((gridDim.x & 7) == 0 && gridDim.x >= 256) { const int x = u & 7, jx = u >> 3; pair = (x * 2 + (jx >> 5)) & 15; qb = jx & 31; }
            if (EN(11)) diff_unit(p, pair >> 2, pair & 3, qb, smem);
          }
          else { const int v = u - 512, nb = v & 7, bc = v >> 3; if (EN(8)) lru_unit(p, bc >> 6, 2 + (bc & 63), nb, 1, smem); }
        }
      }
      break;
    case 9:
      if (!EN(12)) break;
      if (!last) {
        const float* ssq = (const float*)(WSP(p) + OFF_SSQ);
        const int gtid = blockIdx.x * NT + tidx(), gsz = gridDim.x * NT;
        for (int it = gtid; it < TT * 64; it += gsz) {
          const int row = it >> 6, c = (it & 63) * 8;
          const float* sp = ssq + (size_t)row * 16;
          const f32x4 s0 = *(const f32x4*)sp, s1 = *(const f32x4*)(sp + 4), s2 = *(const f32x4*)(sp + 8), s3 = *(const f32x4*)(sp + 12);
          const float tot = (s0[0] + s0[1] + s0[2] + s0[3]) + (s1[0] + s1[1] + s1[2] + s1[3]) + (s2[0] + s2[1] + s2[2] + s2[3]) + (s3[0] + s3[1] + s3[2] + s3[3]);
          const float rs = rsqrtf(tot * (1.f / 512.f) + EPS);
          bf16_t* hp = H + (size_t)row * DM + 512 + c;
          const u32x4 v = *(const u32x4*)hp;
          u32x4 o = {cvtpk(bflo(v.x) * rs, bfhi(v.x) * rs), cvtpk(bflo(v.y) * rs, bfhi(v.y) * rs), cvtpk(bflo(v.z) * rs, bfhi(v.z) * rs), cvtpk(bflo(v.w) * rs, bfhi(v.w) * rs)};
          *(u32x4*)hp = o;
        }
        grid_barrier(bar, ++nbar);
        gemm8(H, (const bf16_t*)(WSP(p) + OFF_WABOUT), TT, DM, DM, Epi8Res{p, modl, 5, 1.0f, false}, smem);
      }
      else gemm8(H, (const bf16_t*)(WSP(p) + OFF_WCDOUT), TL, DM, DM, Epi8Res{p, modl, 5, 1.0f, false}, smem);
      break;
    case 10: if (EN(1)) phase_modnorm(p, layer, 2, false, last ? TL : TT, false); break;
    case 11:
      if (EN(2)) {
        const bf16_t* W = (const bf16_t*)(WSP(p) + OFF_W13) + (size_t)(layer * 2 + 1) * 5632 * DM;
        gemm8(H, W, TL, 5632, DM, Epi8Up{BIG}, smem);
        if (!last) gemm_phase(H + (size_t)TL * DM, DM, W, DM, TC, 5632, 0, nullptr, EpiUp{BIG + (size_t)TL * DFF}, smem);
      }
      break;
    case 12:
      if (EN(3)) ffn_down_phase(p, BIG, (const bf16_t*)(WSP(p) + OFF_W2) + (size_t)(layer * 2 + 1) * DM * DFF, modl, 8, false, !last, smem);
      break;
  }
}


#ifndef PROBE_EMPTY
#define PROBE_EMPTY 0
#endif
__device__ __forceinline__ void grid_barrier(unsigned* bar, unsigned epoch) {
  asm volatile("s_waitcnt vmcnt(0) lgkmcnt(0)" ::: "memory");
  __syncthreads();
  if (tidx() == 0) {
    const unsigned G = gridDim.x, ng = G < 8u ? G : 8u, grp = blockIdx.x & 7u, gs = (G - grp + 7u) >> 3;
    __builtin_amdgcn_fence(__ATOMIC_RELEASE, "agent");
    asm volatile("s_waitcnt vmcnt(0)" ::: "memory");
    if (__hip_atomic_fetch_add(bar + grp * 32, 1u, __ATOMIC_RELAXED, __HIP_MEMORY_SCOPE_AGENT) + 1u == epoch * gs) {
      if (__hip_atomic_fetch_add(bar + 8 * 32, 1u, __ATOMIC_RELAXED, __HIP_MEMORY_SCOPE_AGENT) + 1u == epoch * ng) {
        for (unsigned i = 0; i < ng; ++i) __hip_atomic_store(bar + (16 + i) * 32, epoch, __ATOMIC_RELAXED, __HIP_MEMORY_SCOPE_AGENT);
      }
    }
    while (__hip_atomic_load(bar + (16 + grp) * 32, __ATOMIC_RELAXED, __HIP_MEMORY_SCOPE_AGENT) < epoch) __builtin_amdgcn_s_sleep(1);
    __builtin_amdgcn_fence(__ATOMIC_ACQUIRE, "agent");
    asm volatile("s_waitcnt vmcnt(0)" ::: "memory");
  }
  __syncthreads();
}
__global__ void __launch_bounds__(512) mega(Params p, int p0, int p1) {
  extern __shared__ __attribute__((aligned(16))) char smem[];
  {
    const int key = __builtin_amdgcn_s_getreg((5 << 11) | 4) & 63;
    *(volatile int*)(smem + LDS_WTAB + key * 4) = (int)(__builtin_amdgcn_workitem_id_x() >> 6);
    __syncthreads();
  }
  cg::grid_group grid = cg::this_grid();
  if (p1 < 0) grid.sync();
  unsigned* bar = (unsigned*)(WSP(p) + OFF_BAR);
  unsigned nbar = 0;
  unsigned long long tprobe = 0;
  for (int e = 0; e < PROBE_EMPTY; ++e) grid_barrier(bar, ++nbar);
#ifndef PROBE_PH
#define PROBE_PH -1
#define PROBE_N 0
#endif
  for (int phx = p0; phx < p1 + PROBE_N; ++phx) {
    const int ph = (PROBE_PH >= 0 && phx > PROBE_PH) ? (phx - PROBE_N < PROBE_PH ? PROBE_PH : phx - PROBE_N) : phx;
#ifndef PROBE_T
#define PROBE_T -1
#endif
    unsigned long long t0 = 0;
    if (PROBE_T >= 0 && ph == PROBE_T) t0 = __builtin_amdgcn_s_memrealtime();
    run_phase(p, ph, smem, bar, nbar, PROBE_PH >= 0 && phx > PROBE_PH && phx <= PROBE_PH + PROBE_N);
    if (phx + 1 < p1 + PROBE_N) grid_barrier(bar, ++nbar);
    if (PROBE_T >= 0 && ph == PROBE_T) tprobe += __builtin_amdgcn_s_memrealtime() - t0;
  }
  if (PROBE_T >= 0 && blockIdx.x == 0) {
    const unsigned long long te = __builtin_amdgcn_s_memrealtime();
    while (__builtin_amdgcn_s_memrealtime() - te < 4ull * tprobe) __builtin_amdgcn_s_sleep(8);
  }
}

extern "C" void kernel_launch(void* const* d_in, const int* in_sizes, int n_in, void* d_out, int out_size, void* d_ws,
                              size_t ws_size, hipStream_t stream) {
  constexpr size_t kLds = 147456;
  static int grid_blocks = 0;
  if (!grid_blocks) {
    int dev = 0, cus = 0, per_cu = 0;
    (void)hipGetDevice(&dev);
    (void)hipDeviceGetAttribute(&cus, hipDeviceAttributeMultiprocessorCount, dev);
    (void)hipFuncSetAttribute((const void*)mega, hipFuncAttributeMaxDynamicSharedMemorySize, (int)kLds);
    (void)hipOccupancyMaxActiveBlocksPerMultiprocessor(&per_cu, mega, 512, kLds);
    if (per_cu < 1) per_cu = 1;
    grid_blocks = cus * per_cu;
  }
  Params p{};
  const float** pp = (const float**)&p;
  for (int i = 0; i < 34; ++i) pp[i] = (const float*)d_in[i];
  p.out = (float*)d_out;
  p.ws = (char*)d_ws;
  int p0 = 0, p1 = NPHASE;
  (void)hipMemsetAsync((char*)d_ws + OFF_BAR, 0, 4096, stream);
  void* args[] = {&p, &p0, &p1};
  hipError_t e = hipLaunchCooperativeKernel((void*)mega, dim3(grid_blocks), dim3(512), args, kLds, stream);
  if (e != hipSuccess) fprintf(stderr, "cooperative launch failed: %s (grid %d)\n", hipGetErrorString(e), grid_blocks);
}
```

```cpp
#include <hip/hip_runtime.h>
#include <hip/hip_cooperative_groups.h>
#include <cstdio>
#include <cstddef>
namespace cg = cooperative_groups;

typedef unsigned short bf16_t;
typedef short bf16x8 __attribute__((ext_vector_type(8)));
typedef float f32x4 __attribute__((ext_vector_type(4)));
typedef float f32x16 __attribute__((ext_vector_type(16)));
typedef unsigned u32x4 __attribute__((ext_vector_type(4)));
typedef unsigned u32x2 __attribute__((ext_vector_type(2)));

#define LOG2E 1.4426950408889634f
constexpr int TL = 32768, TC = 1024, TT = TL + TC, DM = 1024, DFF = 2816;
constexpr int NT = 512;
constexpr float EPS = 1e-6f;
constexpr float LAM_INIT = 0.35550906f;

constexpr size_t al256(size_t x) { return (x + 255) & ~(size_t)255; }
constexpr size_t OFF_W13 = 0;
constexpr size_t OFF_W2 = OFF_W13 + (size_t)4 * 5632 * 1024 * 2;
constexpr size_t OFF_WABIN = OFF_W2 + (size_t)4 * 1024 * 2816 * 2;
constexpr size_t OFF_WABOUT = OFF_WABIN + (size_t)3328 * 1024 * 2;
constexpr size_t OFF_WCDIN = OFF_WABOUT + (size_t)1024 * 1024 * 2;
constexpr size_t OFF_WCDOUT = OFF_WCDIN + (size_t)2560 * 1024 * 2;
constexpr size_t OFF_WLRU = OFF_WCDOUT + (size_t)1024 * 1024 * 2;
constexpr size_t OFF_MOD = OFF_WLRU + (size_t)2 * 2 * 8 * 64 * 64 * 2;
constexpr size_t OFF_SCAL = OFF_MOD + (size_t)2 * 5 * 9216 * 4;
constexpr size_t OFF_ROPE = OFF_SCAL + 256;
constexpr size_t OFF_XC = OFF_ROPE + (size_t)192 * 16 * 2 * 4;
constexpr size_t OFF_H = OFF_XC + (size_t)TC * DM * 4;
constexpr size_t OFF_BIG = OFF_H + (size_t)TT * DM * 2;
constexpr size_t OFF_DT = OFF_BIG + (size_t)TT * 3072 * 2;
constexpr size_t OFF_XBC = OFF_DT + (size_t)TT * 16 * 4;
constexpr size_t OFF_ST = OFF_XBC + (size_t)TT * 1024 * 2;
constexpr size_t OFF_DEC = OFF_ST + (size_t)4 * 2 * 8 * 66 * 64 * 128 * 2;
constexpr size_t OFF_SSQ = al256(OFF_DEC + (size_t)4 * 2 * 8 * 66 * 4);
constexpr size_t OFF_LCA = OFF_SSQ + (size_t)TT * 16 * 4;
constexpr size_t OFF_LCH = OFF_LCA + (size_t)4 * 2 * 66 * 512 * 4;
constexpr size_t OFF_LHIN = OFF_LCH + (size_t)4 * 2 * 66 * 512 * 4;
constexpr size_t WS_END = OFF_LHIN + (size_t)4 * 2 * 66 * 512 * 4;
constexpr size_t OFF_BAR = al256(WS_END);
constexpr size_t OFF_PART = al256(OFF_BAR + 4096);
static_assert(OFF_PART + (size_t)2 * TC * DM * 4 <= (size_t)536870912, "workspace too large");

struct Params {
  const float *x, *c, *ctx, *c_ctx, *w_mod, *b_mod, *norm_g, *ffn_w1, *ffn_w3, *ffn_w2, *ab_w_in, *ab_w_out, *na_q_g,
      *na_k_g, *na_rpb, *ssd_conv_w, *ssd_conv_b, *ssd_dt_bias, *ssd_a_log, *ssd_d, *ssd_norm_g, *cd_w_in, *cd_w_out,
      *lru_conv_w, *lru_conv_b, *lru_wa, *lru_ba, *lru_wx, *lru_bx, *lru_lambda, *diff_q_g, *diff_k_g, *diff_lambda,
      *diff_subln_g;
  float* out;
  char* ws;
};

typedef __attribute__((address_space(1))) char gchar_t;
typedef __attribute__((address_space(1))) float gfloat_t;
typedef __attribute__((address_space(1))) const float gcfloat_t;
__device__ __forceinline__ unsigned long long karg_u64(int off) {
  unsigned long long a = (unsigned long long)__builtin_amdgcn_kernarg_segment_ptr();
  asm volatile("" : "+s"(a));
  return *(const __attribute__((address_space(4))) unsigned long long*)(a + (unsigned long long)off);
}
#define WSP(p) ((char*)(gchar_t*)karg_u64((int)offsetof(Params, ws)))
#define OUTP(p) ((float*)(gfloat_t*)karg_u64((int)offsetof(Params, out)))
#define PRM(p, f) ((const float*)(gcfloat_t*)karg_u64((int)offsetof(Params, f)))
constexpr int LDS_TOTAL = 147456, LDS_WTAB = LDS_TOTAL - 256;
extern __shared__ __attribute__((aligned(16))) char smem_base[];
__device__ __forceinline__ int tidx() {
  const int key = __builtin_amdgcn_s_getreg((5 << 11) | 4) & 63;
  int wv = *(const volatile int*)(smem_base + LDS_WTAB + key * 4);
  wv = __builtin_amdgcn_readfirstlane(wv);
  int t = (wv << 6) | (int)__builtin_amdgcn_mbcnt_hi(~0u, __builtin_amdgcn_mbcnt_lo(~0u, 0u));
  asm volatile("" : "+v"(t));
  return t;
}
typedef __bf16 bf16x2_t __attribute__((ext_vector_type(2)));
typedef float f32x2_t __attribute__((ext_vector_type(2)));
__device__ __forceinline__ unsigned cvtpk(float lo, float hi) {
  f32x2_t v = {lo, hi};
  bf16x2_t b = __builtin_convertvector(v, bf16x2_t);
  return __builtin_bit_cast(unsigned, b);
}
__device__ __forceinline__ float bflo(unsigned u) { return __uint_as_float(u << 16); }
__device__ __forceinline__ float bfhi(unsigned u) { return __uint_as_float(u & 0xffff0000u); }
__device__ __forceinline__ float siluf(float v) { return v * __builtin_amdgcn_rcpf(1.f + __expf(-v)); }
__device__ __forceinline__ float sigmf(float v) { return __builtin_amdgcn_rcpf(1.f + __expf(-v)); }
__device__ __forceinline__ float softplusf(float v) { return fmaxf(v, 0.f) + log1pf(__expf(-fabsf(v))); }
__device__ __forceinline__ float gelu_tanh(float v) {
  float u = 0.7978845608028654f * (v + 0.044715f * v * v * v);
  float t = 1.f - 2.f * __builtin_amdgcn_rcpf(1.f + __expf(2.f * u));
  return 0.5f * v * (1.f + t);
}
__device__ __forceinline__ f32x16 mfma32(bf16x8 a, bf16x8 b, f32x16 c) {
  return __builtin_amdgcn_mfma_f32_32x32x16_bf16(a, b, c, 0, 0, 0);
}
__device__ __forceinline__ f32x4 mfma16(bf16x8 a, bf16x8 b, f32x4 c) {
  return __builtin_amdgcn_mfma_f32_16x16x32_bf16(a, b, c, 0, 0, 0);
}
__device__ __forceinline__ bf16x8 ldsfrag16(const char* p) { return *(const bf16x8*)p; }
__device__ __forceinline__ bf16x8 ldsfrag8x2(const char* p0, const char* p1) {
  u32x2 a = *(const u32x2*)p0, b = *(const u32x2*)p1;
  u32x4 t = {a.x, a.y, b.x, b.y};
  return __builtin_bit_cast(bf16x8, t);
}
__device__ __forceinline__ float wave_sum(float v) {
#pragma unroll
  for (int o = 32; o > 0; o >>= 1) v += __shfl_xor(v, o);
  return v;
}
__device__ __forceinline__ float wave_max(float v) {
#pragma unroll
  for (int o = 32; o > 0; o >>= 1) v = fmaxf(v, __shfl_xor(v, o));
  return v;
}
__device__ __forceinline__ int modidx(int row) { return row < TL ? (row >> 13) : 4; }
__device__ __forceinline__ float* xrow(const Params& p, int row) {
  return row < TL ? OUTP(p) + (size_t)row * DM : (float*)(WSP(p) + OFF_XC) + (size_t)(row - TL) * DM;
}
__device__ __forceinline__ const float* xinrow(const Params& p, int row) {
  return row < TL ? PRM(p, x) + (size_t)row * DM : PRM(p, ctx) + (size_t)(row - TL) * DM;
}
__device__ __forceinline__ int chunk_tok0(int b, int cc) { return cc < 2 ? TL + b * 256 + cc * 128 : b * 8192 + (cc - 2) * 128; }

template <bool SCALE>
__device__ __forceinline__ void stage_T(const bf16_t* src, int ld, int nt, int nc, char* dst, int RS, const float* wl) {
  const int nct = nc >> 2, total = (nt >> 2) * nct;
  for (int m = tidx(); m < total; m += NT) {
    const int tc = m % nct, tt = m / nct;
    const bf16_t* s = src + (size_t)(tt * 4) * ld + tc * 4;
    u32x2 v0 = *(const u32x2*)s, v1 = *(const u32x2*)(s + ld), v2 = *(const u32x2*)(s + 2 * ld), v3 = *(const u32x2*)(s + 3 * ld);
    u32x2 o0, o1, o2, o3;
    if (SCALE) {
      const float w0 = wl[tt * 4], w1 = wl[tt * 4 + 1], w2 = wl[tt * 4 + 2], w3 = wl[tt * 4 + 3];
      o0.x = cvtpk(bflo(v0.x) * w0, bflo(v1.x) * w1); o0.y = cvtpk(bflo(v2.x) * w2, bflo(v3.x) * w3);
      o1.x = cvtpk(bfhi(v0.x) * w0, bfhi(v1.x) * w1); o1.y = cvtpk(bfhi(v2.x) * w2, bfhi(v3.x) * w3);
      o2.x = cvtpk(bflo(v0.y) * w0, bflo(v1.y) * w1); o2.y = cvtpk(bflo(v2.y) * w2, bflo(v3.y) * w3);
      o3.x = cvtpk(bfhi(v0.y) * w0, bfhi(v1.y) * w1); o3.y = cvtpk(bfhi(v2.y) * w2, bfhi(v3.y) * w3);
    } else {
      o0.x = (v0.x & 0xffffu) | (v1.x << 16); o0.y = (v2.x & 0xffffu) | (v3.x << 16);
      o1.x = (v0.x >> 16) | (v1.x & 0xffff0000u); o1.y = (v2.x >> 16) | (v3.x & 0xffff0000u);
      o2.x = (v0.y & 0xffffu) | (v1.y << 16); o2.y = (v2.y & 0xffffu) | (v3.y << 16);
      o3.x = (v0.y >> 16) | (v1.y & 0xffff0000u); o3.y = (v2.y >> 16) | (v3.y & 0xffff0000u);
    }
    char* d = dst + (size_t)(tc * 4) * RS + tt * 8;
    *(u32x2*)d = o0; *(u32x2*)(d + RS) = o1; *(u32x2*)(d + 2 * RS) = o2; *(u32x2*)(d + 3 * RS) = o3;
  }
}
__device__ __forceinline__ void stage_N(const bf16_t* src, int ld, int nrows, int rowbytes, char* dst, int RS) {
  const int cpr = rowbytes >> 4, total = nrows * cpr;
  for (int m = tidx(); m < total; m += NT) {
    const int rr = m / cpr, cc = m - rr * cpr;
    *(u32x4*)(dst + (size_t)rr * RS + cc * 16) = *(const u32x4*)(src + (size_t)rr * ld + cc * 8);
  }
}

__device__ __forceinline__ void convert_weights(const Params& p, char* smem, int set, int gw, int nw) {
  const int tid = tidx(), lane = tid & 63, w = tid >> 6;
  float* tile = (float*)smem + w * (64 * 65);
  constexpr int T_FFN = 12 * 704, T_ABIN = T_FFN + 832, T_ABOUT = T_ABIN + 256, T_CDIN = T_ABOUT + 640, T_CDOUT = T_CDIN + 256,
                T_WA = T_CDOUT + 16, T_WX = T_WA + 16;
  const int nset = set == 0 ? 4224 + 1088 : 4224 + 928;
  for (int ti = gw; ti < nset; ti += nw) {
    const int t = set == 0 ? (ti < 4224 ? ti : T_FFN + (ti - 4224)) : (ti < 4224 ? 4224 + ti : T_ABOUT + (ti - 4224));
    const float* src; bf16_t* dst; int K, N, ntn, mode = 0, tl;
    if (t < T_FFN) {
      const int j = t / 704, cidx = j / 3, kind = j - cidx * 3; tl = t - j * 704;
      if (kind == 2) { src = PRM(p, ffn_w2) + (size_t)cidx * DFF * DM; dst = (bf16_t*)(WSP(p) + OFF_W2) + (size_t)cidx * DM * DFF; K = DFF; N = DM; ntn = 16; }
      else { src = (kind == 0 ? PRM(p, ffn_w1) : PRM(p, ffn_w3)) + (size_t)cidx * DM * DFF; dst = (bf16_t*)(WSP(p) + OFF_W13) + (size_t)cidx * 5632 * DM; K = DM; N = DFF; ntn = 44; mode = 1 + kind; }
    } else if (t < T_ABIN) { tl = t - T_FFN; src = PRM(p, ab_w_in); dst = (bf16_t*)(WSP(p) + OFF_WABIN); K = 1024; N = 3088; ntn = 52; }
    else if (t < T_ABOUT) { tl = t - T_ABIN; src = PRM(p, ab_w_out); dst = (bf16_t*)(WSP(p) + OFF_WABOUT); K = 1024; N = 1024; ntn = 16; mode = 3; }
    else if (t < T_CDIN) { tl = t - T_ABOUT; src = PRM(p, cd_w_in); dst = (bf16_t*)(WSP(p) + OFF_WCDIN); K = 1024; N = 2560; ntn = 40; }
    else if (t < T_CDOUT) { tl = t - T_CDIN; src = PRM(p, cd_w_out); dst = (bf16_t*)(WSP(p) + OFF_WCDOUT); K = 1024; N = 1024; ntn = 16; }
    else if (t < T_WA) { tl = t - T_CDOUT; src = PRM(p, lru_wa) + (size_t)tl * 4096; dst = (bf16_t*)(WSP(p) + OFF_WLRU) + (size_t)tl * 4096; K = 64; N = 64; ntn = 1; tl = 0; }
    else { tl = t - T_WA; src = PRM(p, lru_wx) + (size_t)tl * 4096; dst = (bf16_t*)(WSP(p) + OFF_WLRU) + (size_t)(16 + tl) * 4096; K = 64; N = 64; ntn = 1; tl = 0; }
    const int tk = tl / ntn, tn = tl - tk * ntn, k0 = tk * 64, n0 = tn * 64;
#pragma unroll 4
    for (int it = 0; it < 16; ++it) {
      const int idx = it * 64 + lane, kk = idx >> 4, n4 = (idx & 15) * 4;
      f32x4 v = {0.f, 0.f, 0.f, 0.f};
      if (n0 + n4 < N) v = *(const f32x4*)(src + (size_t)(k0 + kk) * N + n0 + n4);
      float* tp = tile + kk * 65 + n4;
      tp[0] = v[0]; tp[1] = v[1]; tp[2] = v[2]; tp[3] = v[3];
    }
    __builtin_amdgcn_wave_barrier();
#pragma unroll 2
    for (int it = 0; it < 8; ++it) {
      const int idx = it * 64 + lane, nn = idx >> 3, kc = idx & 7;
      float e[8];
#pragma unroll
      for (int j = 0; j < 8; ++j) e[j] = tile[(kc * 8 + j) * 65 + nn];
      if (mode == 3 && k0 >= 512) {
#pragma unroll
        for (int j = 0; j < 8; ++j) e[j] *= PRM(p, ssd_norm_g)[k0 - 512 + kc * 8 + j];
      }
      const int n = n0 + nn;
      int rho = n;
      if (mode == 1 || mode == 2) rho = 32 * (n >> 4) + 16 * (mode - 1) + (n & 15);
      u32x4 o = {cvtpk(e[0], e[1]), cvtpk(e[2], e[3]), cvtpk(e[4], e[5]), cvtpk(e[6], e[7])};
      *(u32x4*)(dst + (size_t)rho * K + k0 + kc * 8) = o;
    }
    __builtin_amdgcn_wave_barrier();
  }
}

#ifndef PROBE_SUB
#define PROBE_SUB 0
#endif
__device__ __forceinline__ void phase_prep(const Params& p, char* smem, int sub) {
  const int tid = tidx(), lane = tid & 63, w = tid >> 6;
  float* modb = (float*)(WSP(p) + OFF_MOD);
  const int ngemv = gridDim.x >= 128 ? 64 : 0;
  for (int u = blockIdx.x; u < 64; u += (ngemv ? 64 * 1024 : gridDim.x)) {
    if (sub == 2) break;
    const int l = u >> 5, k0 = (u & 31) * 32;
    float* sl = (float*)smem;
    __syncthreads();
    if (tid < 160) {
      const int idx = tid >> 5, kk = tid & 31;
      const float v = idx < 4 ? PRM(p, c)[idx * 1024 + k0 + kk] : PRM(p, c_ctx)[k0 + kk];
      sl[tid] = v / (1.f + expf(-v));
    }
    __syncthreads();
    f32x4 acc[5][5];
#pragma unroll
    for (int a = 0; a < 5; ++a)
#pragma unroll
      for (int q = 0; q < 5; ++q) acc[a][q] = (f32x4){0.f, 0.f, 0.f, 0.f};
    const float* wbase = PRM(p, w_mod) + ((size_t)l * 1024 + k0) * 9216;
    const bool tail = tid < 256;
#pragma unroll 2
    for (int kk = 0; kk < 32; ++kk) {
      const float* rowp = wbase + (size_t)kk * 9216 + tid * 4;
      f32x4 wv[5];
#pragma unroll
      for (int q = 0; q < 4; ++q) wv[q] = __builtin_nontemporal_load((const f32x4*)(rowp + q * 2048));
      wv[4] = tail ? __builtin_nontemporal_load((const f32x4*)(rowp + 4 * 2048)) : (f32x4){0.f, 0.f, 0.f, 0.f};
#pragma unroll
      for (int a = 0; a < 5; ++a) {
        const float sv = sl[a * 32 + kk];
#pragma unroll
        for (int q = 0; q < 5; ++q) acc[a][q] += sv * wv[q];
      }
    }
    float* P = (float*)(WSP(p) + OFF_BIG) + (size_t)u * 5 * 9216;
#pragma unroll
    for (int a = 0; a < 5; ++a)
#pragma unroll
      for (int q = 0; q < 5; ++q)
        if (q < 4 || tail) *(f32x4*)(P + (size_t)a * 9216 + q * 2048 + tid * 4) = acc[a][q];
  }
  __syncthreads();
  if (blockIdx.x == gridDim.x - 1) {
    float* red = (float*)smem;
    float mr = 0.f;
#pragma unroll
    for (int q = 0; q < 8; ++q) { const int i = tid + q * NT; if (i < 8 * 15 * 31) mr = fmaxf(mr, fabsf(PRM(p, na_rpb)[i])); }
    mr = wave_max(mr);
    if (lane == 0) red[w] = mr;
    __syncthreads();
    if (w == 0) {
      float* sc = (float*)(WSP(p) + OFF_SCAL);
      mr = fmaxf(fmaxf(fmaxf(red[0], red[1]), fmaxf(red[2], red[3])), fmaxf(fmaxf(red[4], red[5]), fmaxf(red[6], red[7])));
      const float mq = wave_max(fabsf(PRM(p, na_q_g)[lane])), mk = wave_max(fabsf(PRM(p, na_k_g)[lane]));
      const float dq = wave_max(fabsf(PRM(p, diff_q_g)[lane])), dk = wave_max(fabsf(PRM(p, diff_k_g)[lane]));
      const float s1 = wave_sum(PRM(p, diff_lambda)[lane] * PRM(p, diff_lambda)[64 + lane]);
      const float s2 = wave_sum(PRM(p, diff_lambda)[128 + lane] * PRM(p, diff_lambda)[192 + lane]);
      if (lane == 0) {
        float eight = 8.f;
        asm volatile("" : "+v"(eight));
        sc[0] = (eight * mq * mk + mr) * LOG2E;
        sc[1] = eight * dq * dk * LOG2E;
        sc[2] = expf(s1) - expf(s2) + LAM_INIT;
      }
    }
    __syncthreads();
  }
  if (blockIdx.x == (gridDim.x > 1 ? gridDim.x - 2 : 0)) {
    float* rt = (float*)(WSP(p) + OFF_ROPE);
    for (int i = tid; i < 192 * 16; i += NT) {
      const int pos = i >> 4, m = i & 15;
      const float inv = exp2f(-(float)m * (13.287712379549449f / 16.f));
      const float ang = (float)(pos < 128 ? pos : pos - 128) * inv;
      float sn, cs;
      sincosf(ang, &sn, &cs);
      rt[i * 2] = cs; rt[i * 2 + 1] = sn;
    }
  }
  if (sub != 1) {
    if (ngemv == 0) convert_weights(p, smem, 0, blockIdx.x * 8 + w, gridDim.x * 8);
    else if ((int)blockIdx.x >= 64) convert_weights(p, smem, 0, ((int)blockIdx.x - 64) * 8 + w, ((int)gridDim.x - 64) * 8);
  }
}

__device__ __forceinline__ void phase_modreduce(const Params& p) {
  const float* P = (const float*)(WSP(p) + OFF_BIG);
  float* modb = (float*)(WSP(p) + OFF_MOD);
  const int gtid = blockIdx.x * NT + tidx(), gsz = gridDim.x * NT;
  for (int o = gtid; o < 2 * 5 * 2304; o += gsz) {
    const int l = o / (5 * 2304), r = o - l * 5 * 2304, idx = r / 2304, f = r - idx * 2304;
    f32x4 acc = *(const f32x4*)(PRM(p, b_mod) + (size_t)l * 9216 + f * 4);
#pragma unroll 8
    for (int sl = 0; sl < 32; ++sl) acc += *(const f32x4*)(P + ((size_t)(l * 32 + sl) * 5 + idx) * 9216 + f * 4);
    *(f32x4*)(modb + ((size_t)l * 5 + idx) * 9216 + f * 4) = acc;
  }
}

__device__ __forceinline__ void phase_modnorm(const Params& p, int layer, int k, bool from_input, int nrows, bool fold) {
  const int lane = tidx() & 63, w = tidx() >> 6;
  const float* g = PRM(p, norm_g) + ((size_t)layer * 3 + k) * DM;
  const float* modb = (const float*)(WSP(p) + OFF_MOD) + (size_t)layer * 5 * 9216;
  bf16_t* H = (bf16_t*)(WSP(p) + OFF_H);
  const int stride = gridDim.x * 8;
  for (int row0 = blockIdx.x * 8 + w; row0 < nrows; row0 += 2 * stride) {
    const int row1 = row0 + stride;
    const bool has1 = row1 < nrows;
    const float* xr0 = from_input ? xinrow(p, row0) : xrow(p, row0);
    const float* xr1 = has1 ? (from_input ? xinrow(p, row1) : xrow(p, row1)) : xr0;
    f32x4 v0[4], v1[4];
#pragma unroll
    for (int i = 0; i < 4; ++i) { v0[i] = *(const f32x4*)(xr0 + i * 256 + lane * 4); v1[i] = *(const f32x4*)(xr1 + i * 256 + lane * 4); }
    if (fold) {
      const float* P = (const float*)(WSP(p) + OFF_PART);
      if (row0 >= TL) {
        float* xw = (float*)(WSP(p) + OFF_XC) + (size_t)(row0 - TL) * DM;
#pragma unroll
        for (int i = 0; i < 4; ++i) {
          const size_t o = (size_t)(row0 - TL) * DM + i * 256 + lane * 4;
          v0[i] += *(const f32x4*)(P + o) + *(const f32x4*)(P + (size_t)TC * DM + o);
          *(f32x4*)(xw + i * 256 + lane * 4) = v0[i];
        }
      }
      if (has1 && row1 >= TL) {
        float* xw = (float*)(WSP(p) + OFF_XC) + (size_t)(row1 - TL) * DM;
#pragma unroll
        for (int i = 0; i < 4; ++i) {
          const size_t o = (size_t)(row1 - TL) * DM + i * 256 + lane * 4;
          v1[i] += *(const f32x4*)(P + o) + *(const f32x4*)(P + (size_t)TC * DM + o);
          *(f32x4*)(xw + i * 256 + lane * 4) = v1[i];
        }
      }
    }
    float s0 = 0.f, s1 = 0.f;
#pragma unroll
    for (int i = 0; i < 4; ++i) {
      s0 += v0[i][0] * v0[i][0] + v0[i][1] * v0[i][1] + v0[i][2] * v0[i][2] + v0[i][3] * v0[i][3];
      s1 += v1[i][0] * v1[i][0] + v1[i][1] * v1[i][1] + v1[i][2] * v1[i][2] + v1[i][3] * v1[i][3];
    }
    s0 = wave_sum(s0); s1 = wave_sum(s1);
    const float r0 = rsqrtf(s0 * (1.f / 1024.f) + EPS), r1 = rsqrtf(s1 * (1.f / 1024.f) + EPS);
    const float* m0 = modb + (size_t)modidx(row0) * 9216 + (3 * k) * 1024;
    const float* m1 = modb + (size_t)modidx(has1 ? row1 : row0) * 9216 + (3 * k) * 1024;
#pragma unroll
    for (int i = 0; i < 4; ++i) {
      const int col = i * 256 + lane * 4;
      const f32x4 gg = *(const f32x4*)(g + col);
      const f32x4 sh0 = *(const f32x4*)(m0 + col), sc0 = *(const f32x4*)(m0 + 1024 + col);
      float o[4];
#pragma unroll
      for (int jx = 0; jx < 4; ++jx) o[jx] = (v0[i][jx] * r0 * gg[jx]) * (1.f + sc0[jx]) + sh0[jx];
      u32x2 pk = {cvtpk(o[0], o[1]), cvtpk(o[2], o[3])};
      *(u32x2*)(H + (size_t)row0 * DM + col) = pk;
      if (has1) {
        const f32x4 sh1 = *(const f32x4*)(m1 + col), sc1 = *(const f32x4*)(m1 + 1024 + col);
#pragma unroll
        for (int jx = 0; jx < 4; ++jx) o[jx] = (v1[i][jx] * r1 * gg[jx]) * (1.f + sc1[jx]) + sh1[jx];
        u32x2 pk1 = {cvtpk(o[0], o[1]), cvtpk(o[2], o[3])};
        *(u32x2*)(H + (size_t)row1 * DM + col) = pk1;
      }
    }
  }
}

constexpr int G_STAGE = 55296;
template <class Epi>
__device__ __forceinline__ void gemm_phase(const bf16_t* A, int lda, const bf16_t* Bt, int K, int Mrows, int N, int koff,
                                           const float* ssq, Epi epi, char* smem) {
  const int tid = tidx(), lane = tid & 63, w = tid >> 6, wr = w >> 1, wc = w & 1, r = lane & 15, q = lane >> 4;
  const int nN = N / 128, nunits = (Mrows / 256) * nN, nk = K / 64;
  const int lrow = tid >> 3, lkc = tid & 7;
  for (int unit = blockIdx.x; unit < nunits; unit += gridDim.x) {
    const int pm = unit / nN, pn = unit - pm * nN;
    const int row0 = pm * 256, col0 = pn * 128;
    f32x4 acc[4][4];
#pragma unroll
    for (int mi = 0; mi < 4; ++mi)
#pragma unroll
      for (int ni = 0; ni < 4; ++ni) acc[mi][ni] = (f32x4){0.f, 0.f, 0.f, 0.f};
    const bf16_t* gA = A + (size_t)(row0 + lrow) * lda + lkc * 8;
    const bf16_t* gB = Bt + (size_t)(col0 + lrow) * K + lkc * 8;
    u32x4 ra[4], rb[2];
    {
      const int kt = koff;
#pragma unroll
      for (int i = 0; i < 4; ++i) ra[i] = *(const u32x4*)(gA + (size_t)i * 64 * lda + kt * 64);
#pragma unroll
      for (int i = 0; i < 2; ++i) rb[i] = *(const u32x4*)(gB + (size_t)i * 64 * K + kt * 64);
      char* sa = smem;
#pragma unroll
      for (int i = 0; i < 4; ++i) *(u32x4*)(sa + (lrow + i * 64) * 144 + lkc * 16) = ra[i];
#pragma unroll
      for (int i = 0; i < 2; ++i) *(u32x4*)(sa + 36864 + (lrow + i * 64) * 144 + lkc * 16) = rb[i];
    }
    __syncthreads();
    for (int it = 0; it < nk; ++it) {
      if (it + 1 < nk) {
        int kt = it + 1 + koff; if (kt >= nk) kt -= nk;
#pragma unroll
        for (int i = 0; i < 4; ++i) ra[i] = *(const u32x4*)(gA + (size_t)i * 64 * lda + kt * 64);
#pragma unroll
        for (int i = 0; i < 2; ++i) rb[i] = *(const u32x4*)(gB + (size_t)i * 64 * K + kt * 64);
      }
      const char* sa = smem + (it & 1) * G_STAGE;
      const char* sb = sa + 36864;
#pragma unroll
      for (int ks = 0; ks < 2; ++ks) {
        bf16x8 af[4], bfr[4];
#pragma unroll
        for (int mi = 0; mi < 4; ++mi) af[mi] = ldsfrag16(sa + (wr * 64 + mi * 16 + r) * 144 + ks * 64 + q * 16);
#pragma unroll
        for (int ni = 0; ni < 4; ++ni) bfr[ni] = ldsfrag16(sb + (wc * 64 + ni * 16 + r) * 144 + ks * 64 + q * 16);
#pragma unroll
        for (int mi = 0; mi < 4; ++mi)
#pragma unroll
          for (int ni = 0; ni < 4; ++ni) acc[mi][ni] = mfma16(bfr[ni], af[mi], acc[mi][ni]);
      }
      if (ssq != nullptr && it == 7) {
#pragma unroll
        for (int mi = 0; mi < 4; ++mi) {
          const float* sp = ssq + (size_t)(row0 + wr * 64 + mi * 16 + r) * 16;
          const f32x4 s0 = *(const f32x4*)sp, s1 = *(const f32x4*)(sp + 4), s2 = *(const f32x4*)(sp + 8), s3 = *(const f32x4*)(sp + 12);
          const float tot = (s0[0] + s0[1] + s0[2] + s0[3]) + (s1[0] + s1[1] + s1[2] + s1[3]) + (s2[0] + s2[1] + s2[2] + s2[3]) + (s3[0] + s3[1] + s3[2] + s3[3]);
          const float rs = rsqrtf(tot * (1.f / 512.f) + EPS);
#pragma unroll
          for (int ni = 0; ni < 4; ++ni) acc[mi][ni] *= rs;
        }
      }
      if (it + 1 < nk) {
        char* da = smem + ((it + 1) & 1) * G_STAGE;
#pragma unroll
        for (int i = 0; i < 4; ++i) *(u32x4*)(da + (lrow + i * 64) * 144 + lkc * 16) = ra[i];
#pragma unroll
        for (int i = 0; i < 2; ++i) *(u32x4*)(da + 36864 + (lrow + i * 64) * 144 + lkc * 16) = rb[i];
      }
      __syncthreads();
    }
    epi(acc, row0 + wr * 64, col0 + wc * 64, r, q);
  }
}

struct EpiUp {
  bf16_t* G;
  __device__ __forceinline__ void operator()(f32x4 (&acc)[4][4], int rowb, int colb, int r, int q) const {
#pragma unroll
    for (int mi = 0; mi < 4; ++mi) {
      const int row = rowb + mi * 16 + r;
#pragma unroll
      for (int pr = 0; pr < 2; ++pr) {
        const f32x4 g = acc[mi][2 * pr], u = acc[mi][2 * pr + 1];
        const int col = (colb >> 1) + pr * 16 + 4 * q;
        u32x2 o = {cvtpk(siluf(g[0]) * u[0], siluf(g[1]) * u[1]), cvtpk(siluf(g[2]) * u[2], siluf(g[3]) * u[3])};
        *(u32x2*)(G + (size_t)row * DFF + col) = o;
      }
    }
  }
};
struct EpiRes {
  Params p; const float* modl; int gate; float scale; bool from_input; int rowoff;
  __device__ __forceinline__ void operator()(f32x4 (&acc)[4][4], int rowb, int colb, int r, int q) const {
#pragma unroll
    for (int mi = 0; mi < 4; ++mi) {
      const int row = rowoff + rowb + mi * 16 + r;
      const float* src = from_input ? xinrow(p, row) : xrow(p, row);
      float* dst = xrow(p, row);
      const float* mrow = modl + (size_t)modidx(row) * 9216 + gate * 1024;
#pragma unroll
      for (int ni = 0; ni < 4; ++ni) {
        const int col = colb + ni * 16 + 4 * q;
        const f32x4 s = *(const f32x4*)(src + col), m = *(const f32x4*)(mrow + col);
        f32x4 o;
#pragma unroll
        for (int j = 0; j < 4; ++j) o[j] = s[j] + scale * m[j] * acc[mi][ni][j];
        *(f32x4*)(dst + col) = o;
      }
    }
  }
};
struct EpiInAB {
  bf16_t* U; float* DT; const float* dtb;
  __device__ __forceinline__ void operator()(f32x4 (&acc)[4][4], int rowb, int colb, int r, int q) const {
#pragma unroll
    for (int mi = 0; mi < 4; ++mi) {
      const int row = rowb + mi * 16 + r;
#pragma unroll
      for (int ni = 0; ni < 4; ++ni) {
        const int col = colb + ni * 16 + 4 * q;
        if (col < 3072) {
          u32x2 o = {cvtpk(acc[mi][ni][0], acc[mi][ni][1]), cvtpk(acc[mi][ni][2], acc[mi][ni][3])};
          *(u32x2*)(U + (size_t)row * 3072 + col) = o;
        } else if (col < 3088) {
          f32x4 o;
#pragma unroll
          for (int j = 0; j < 4; ++j) o[j] = softplusf(acc[mi][ni][j] + dtb[col - 3072 + j]);
          *(f32x4*)(DT + (size_t)row * 16 + col - 3072) = o;
        }
      }
    }
  }
};
struct EpiBf {
  bf16_t* U; int ld;
  __device__ __forceinline__ void operator()(f32x4 (&acc)[4][4], int rowb, int colb, int r, int q) const {
#pragma unroll
    for (int mi = 0; mi < 4; ++mi) {
      const int row = rowb + mi * 16 + r;
#pragma unroll
      for (int ni = 0; ni < 4; ++ni) {
        const int col = colb + ni * 16 + 4 * q;
        u32x2 o = {cvtpk(acc[mi][ni][0], acc[mi][ni][1]), cvtpk(acc[mi][ni][2], acc[mi][ni][3])};
        *(u32x2*)(U + (size_t)row * ld + col) = o;
      }
    }
  }
};

namespace pg8 {
#define PG8_LAS __attribute__((address_space(3)))
typedef unsigned short bf16_t;
typedef short bf16x8 __attribute__((ext_vector_type(8)));
typedef float f32x4 __attribute__((ext_vector_type(4)));
typedef unsigned u32x4 __attribute__((ext_vector_type(4)));
constexpr int BM = 256, BK = 64, HALF = 128, HTB = HALF * BK * 2  , STAGE_BYTES = 8 * HTB, NXCD = 8, WGM = 8;

__host__ __device__ __forceinline__ int lds_byte(int r, int c) { const int st = (r >> 4) * 2 + (c >> 5), rr = r & 15, cc = c & 31, ob = rr * 64 + cc * 2; return st * 1024 + (ob ^ (((ob >> 9) & 1) << 5)); }
__host__ __device__ __forceinline__ void stage_rc(int b, int& R, int& C) { const int st = b / 1024, sb = b % 1024, swz = sb ^ (((sb >> 9) & 1) << 5); R = (st >> 1) * 16 + swz / 64; C = (st & 1) * 32 + (swz % 64) / 2; }
__host__ __device__ __forceinline__ int perm32(int rho) { const int n = rho >> 4, i = rho & 15; return 8 * (i >> 2) + 4 * n + (i & 3); }

struct Unit { int pm, pn; };
struct Gemm { const bf16_t* A; const bf16_t* Bt; int M, N, K, ld; };

struct StaticOrder {
    int nM, nN, nwg, G, c;
    __host__ __device__ void init(int M, int N, int G_, int c_) { nM = M / BM; nN = N / BM; nwg = nM * nN; G = G_; c = c_; }
    __host__ __device__ bool next(int i, Unit& u) const {
        const long L = (long)i * G + c; if (L >= nwg) return false;
        int wgid = (int)L; { const int q = nwg / NXCD, r = nwg % NXCD, xcd = wgid % NXCD, off = wgid / NXCD; wgid = (xcd < r ? xcd * (q + 1) : r * (q + 1) + (xcd - r) * q) + off; }
        const int nig = WGM * nN, gid = wgid / nig, fm = gid * WGM, gsz = (nM - fm) < WGM ? (nM - fm) : WGM;
        u.pm = fm + ((wgid % nig) % gsz); u.pn = (wgid % nig) / gsz; return true;
    }
    __device__ __forceinline__ void a_ready(const Unit&) const {}
    __device__ __forceinline__ void done(const Unit&) const {}
};
template <class Epi, class Sched, bool STAMP = false>
__device__ __forceinline__ void gemm_phase(PG8_LAS unsigned char* lds, const Gemm g, const Sched& S, const Epi& E, unsigned long long* stamps) {
    const int tid = tidx(), wid = __builtin_amdgcn_readfirstlane(tid >> 6), lane = tid & 63, wr = wid >> 2, wc = wid & 3, fr = lane & 15, fq = lane >> 4;
    const int K = g.ld, nt = g.K / BK;
    int ts_lo = 0, ts_hi = 0, nts = 0; const unsigned long long rt_entry = STAMP ? (unsigned long long)wall_clock64() : 0ull;
#define PG8_STAMP() do { if (STAMP && wid == 0 && nts < 64) { const unsigned long long _c = (unsigned long long)clock64(); \
        ts_lo = (lane == nts) ? (int)(unsigned)_c : ts_lo; ts_hi = (lane == nts) ? (int)(unsigned)(_c >> 32) : ts_hi; ++nts; } } while (0)
    PG8_STAMP();
    unsigned voffA[2], voffB[2];
#pragma unroll
    for (int i = 0; i < 2; ++i) { int R, C; stage_rc(tid * 16 + i * 8192, R, C); const int Rb = Epi::PERM ? ((R & ~31) + perm32(R & 31)) : R;
        voffA[i] = (unsigned)(R * K + C) * 2u; voffB[i] = (unsigned)(Rb * K + C) * 2u; }
    const size_t kstep = (size_t)(BK * 2);
    const size_t hstep = (size_t)HALF * K * 2;
    const size_t tstep = 2 * hstep;
    const unsigned ldsw = (unsigned)wid * 1024u;
    const int aoff = lds_byte(wr * 64 + fr, fq * 8), boff = lds_byte(wc * 32 + fr, fq * 8);
#define PG8_SA(b, h) (((b) * 2 + (h)) * HTB)
#define PG8_SB(b, h) ((4 + (b) * 2 + (h)) * HTB)
#define PG8_STAGE(bufoff, gbase, voff) do { _Pragma("unroll") for (int _i = 0; _i < 2; ++_i) \
        __builtin_amdgcn_global_load_lds((const unsigned*)((const char*)(gbase) + (voff)[_i]), (PG8_LAS unsigned*)(lds + (bufoff) + ldsw + _i * 8192), 16, 0, 0); } while (0)
#define PG8_LDA(dst, b, h) do { _Pragma("unroll") for (int m = 0; m < 4; ++m) _Pragma("unroll") for (int k = 0; k < 2; ++k) dst[m][k] = *(const PG8_LAS bf16x8*)(lds + PG8_SA(b, h) + aoff + m * 2048 + k * 1024); } while (0)
#define PG8_LDB(dst, b, h) do { _Pragma("unroll") for (int n = 0; n < 2; ++n) _Pragma("unroll") for (int k = 0; k < 2; ++k) dst[n][k] = *(const PG8_LAS bf16x8*)(lds + PG8_SB(b, h) + boff + n * 2048 + k * 1024); } while (0)
#define PG8_MMA(ai, bj, At, Bt) do { __builtin_amdgcn_s_setprio(1); _Pragma("unroll") for (int m = 0; m < 4; ++m) _Pragma("unroll") for (int n = 0; n < 2; ++n) _Pragma("unroll") for (int k = 0; k < 2; ++k) \
        acc[ai][bj][m][n] = __builtin_amdgcn_mfma_f32_16x16x32_bf16(Bt[n][k], At[m][k], acc[ai][bj][m][n], 0, 0, 0); __builtin_amdgcn_s_setprio(0); } while (0)
#define PG8_WAIT_V(n) asm volatile("s_waitcnt vmcnt(" #n ")" ::: "memory")
#define PG8_WAIT_L(n) asm volatile("s_waitcnt lgkmcnt(" #n ")" ::: "memory")
#define PG8_BAR __builtin_amdgcn_s_barrier()
#define PG8_SCHED __builtin_amdgcn_sched_barrier(0)
    Unit cur, nxt; int ui = 0;
    if (!S.next(0, cur)) return;
    f32x4 acc[2][2][4][2];
#pragma unroll
    for (int a = 0; a < 2; ++a)
#pragma unroll
        for (int b = 0; b < 2; ++b)
#pragma unroll
            for (int m = 0; m < 4; ++m)
#pragma unroll
                for (int n = 0; n < 2; ++n) acc[a][b][m][n] = (f32x4){0.f, 0.f, 0.f, 0.f};
    bf16x8 At[4][2], B0[2][2], B1[2][2];
    const char* cA = (const char*)g.A + (size_t)cur.pm * tstep; const char* cB = (const char*)g.Bt + (size_t)cur.pn * tstep;
    S.a_ready(cur);
    PG8_STAGE(PG8_SB(0, 0), cB, voffB); PG8_STAGE(PG8_SA(0, 0), cA, voffA); PG8_STAGE(PG8_SB(0, 1), cB + hstep, voffB); PG8_STAGE(PG8_SA(0, 1), cA + hstep, voffA);
    if (wr == 1) PG8_BAR;
    PG8_WAIT_V(4); PG8_BAR;
    PG8_STAGE(PG8_SB(1, 0), cB + kstep, voffB); PG8_STAGE(PG8_SA(1, 0), cA + kstep, voffA); PG8_STAGE(PG8_SB(1, 1), cB + hstep + kstep, voffB);
    PG8_WAIT_V(6); PG8_BAR;
    PG8_STAMP();
    for (;;) {
        const bool has_next = S.next(ui + 1, nxt);
        const char* nA = has_next ? (const char*)g.A + (size_t)nxt.pm * tstep : cA; const char* nB = has_next ? (const char*)g.Bt + (size_t)nxt.pn * tstep : cB;
        for (int t = 0; t < nt; t += 2) {
            const bool last = (t == nt - 2);
            const char* a1 = cA + (size_t)(t + 1) * kstep;
            const char* a2 = last ? nA : cA + (size_t)(t + 2) * kstep; const char* b2 = last ? nB : cB + (size_t)(t + 2) * kstep;
            const char* a3 = a2 + kstep; const char* b3 = b2 + kstep;
            if (last && has_next) S.a_ready(nxt);
            PG8_LDB(B0, 0, 0); PG8_SCHED; PG8_LDA(At, 0, 0); PG8_STAGE(PG8_SA(1, 1), a1 + hstep, voffA);
            PG8_WAIT_L(8); PG8_BAR; PG8_WAIT_L(0); PG8_MMA(0, 0, At, B0); PG8_BAR; PG8_SCHED;
            PG8_LDB(B1, 0, 1); PG8_STAGE(PG8_SB(0, 0), b2, voffB);
            PG8_BAR; PG8_WAIT_L(0); PG8_MMA(0, 1, At, B1); PG8_BAR;
            PG8_LDA(At, 0, 1); PG8_STAGE(PG8_SA(0, 0), a2, voffA);
            PG8_BAR; PG8_WAIT_L(0); PG8_MMA(1, 0, At, B0); PG8_BAR; PG8_SCHED;
            PG8_STAGE(PG8_SB(0, 1), b2 + hstep, voffB);
            PG8_WAIT_V(6); PG8_BAR; PG8_MMA(1, 1, At, B1); PG8_BAR;
            PG8_LDB(B0, 1, 0); PG8_SCHED; PG8_LDA(At, 1, 0); PG8_STAGE(PG8_SA(0, 1), a2 + hstep, voffA);
            PG8_WAIT_L(8); PG8_BAR; PG8_WAIT_L(0); PG8_MMA(0, 0, At, B0); PG8_BAR; PG8_SCHED;
            PG8_LDB(B1, 1, 1); PG8_STAGE(PG8_SB(1, 0), b3, voffB);
            PG8_BAR; PG8_WAIT_L(0); PG8_MMA(0, 1, At, B1); PG8_BAR;
            PG8_LDA(At, 1, 1); PG8_STAGE(PG8_SA(1, 0), a3, voffA);
            PG8_BAR; PG8_WAIT_L(0); PG8_MMA(1, 0, At, B0); PG8_BAR; PG8_SCHED;
            PG8_STAGE(PG8_SB(1, 1), b3 + hstep, voffB);
            PG8_WAIT_V(6); PG8_BAR; PG8_MMA(1, 1, At, B1); PG8_BAR;
        }
        PG8_STAMP();
        if constexpr (!Epi::AFTER_DRAIN) { E(acc, cur, wr, wc, fr, fq); S.done(cur); }
        PG8_STAMP();
        if (!has_next) break;
#pragma unroll
        for (int a = 0; a < 2; ++a)
#pragma unroll
            for (int b = 0; b < 2; ++b)
#pragma unroll
                for (int m = 0; m < 4; ++m)
#pragma unroll
                    for (int n = 0; n < 2; ++n) acc[a][b][m][n] = (f32x4){0.f, 0.f, 0.f, 0.f};
        cur = nxt; cA = nA; cB = nB; ++ui;
    }
    PG8_WAIT_V(0);
    if (wr == 0) PG8_BAR;
    PG8_BAR;
    if constexpr (Epi::AFTER_DRAIN) { E.fused(acc, cur, wr, wc, fr, fq, lds, wid, lane); S.done(cur); }
    PG8_STAMP();
    if (STAMP && wid == 0) { stamps[lane] = lane < nts ? (((unsigned long long)(unsigned)ts_hi << 32) | (unsigned)ts_lo) : 0ull;
        if (lane == 62) stamps[62] = rt_entry; if (lane == 63) stamps[63] = (unsigned long long)wall_clock64(); }
#undef PG8_STAMP
#undef PG8_SA
#undef PG8_SB
#undef PG8_STAGE
#undef PG8_LDA
#undef PG8_LDB
#undef PG8_MMA
#undef PG8_WAIT_V
#undef PG8_WAIT_L
#undef PG8_BAR
#undef PG8_SCHED
}
}

struct Epi8Up {
  static constexpr bool PERM = false, AFTER_DRAIN = false;
  bf16_t* G;
  __device__ __forceinline__ void operator()(const f32x4 (&acc)[2][2][4][2], const pg8::Unit& u, int wr, int wc, int fr, int fq) const {
#pragma unroll
    for (int ai = 0; ai < 2; ++ai)
#pragma unroll
      for (int m = 0; m < 4; ++m) {
        const int row = u.pm * 256 + ai * 128 + wr * 64 + m * 16 + fr;
#pragma unroll
        for (int bj = 0; bj < 2; ++bj) {
          const f32x4 g = acc[ai][bj][m][0], v = acc[ai][bj][m][1];
          const int col = ((u.pn * 256 + bj * 128 + wc * 32) >> 1) + 4 * fq;
          u32x2 o = {cvtpk(siluf(g[0]) * v[0], siluf(g[1]) * v[1]), cvtpk(siluf(g[2]) * v[2], siluf(g[3]) * v[3])};
          *(u32x2*)(G + (size_t)row * DFF + col) = o;
        }
      }
  }
};
struct Epi8Res {
  static constexpr bool PERM = false, AFTER_DRAIN = false;
  Params p; const float* modl; int gate; float scale; bool from_input;
  __device__ __forceinline__ void operator()(const f32x4 (&acc)[2][2][4][2], const pg8::Unit& u, int wr, int wc, int fr, int fq) const {
#pragma unroll
    for (int ai = 0; ai < 2; ++ai)
#pragma unroll
      for (int m = 0; m < 4; ++m) {
        const int row = u.pm * 256 + ai * 128 + wr * 64 + m * 16 + fr;
        const float* src = from_input ? xinrow(p, row) : xrow(p, row);
        float* dst = xrow(p, row);
        const float* mrow = modl + (size_t)modidx(row) * 9216 + gate * 1024;
#pragma unroll
        for (int bj = 0; bj < 2; ++bj)
#pragma unroll
          for (int n = 0; n < 2; ++n) {
            const int col = u.pn * 256 + bj * 128 + wc * 32 + n * 16 + 4 * fq;
            const f32x4 sv = *(const f32x4*)(src + col), mv = *(const f32x4*)(mrow + col);
            f32x4 o;
#pragma unroll
            for (int j = 0; j < 4; ++j) o[j] = sv[j] + scale * mv[j] * acc[ai][bj][m][n][j];
            *(f32x4*)(dst + col) = o;
          }
      }
  }
};
struct Epi8InAB {
  static constexpr bool PERM = false, AFTER_DRAIN = false;
  bf16_t* U; float* DT; const float* dtb;
  __device__ __forceinline__ void operator()(const f32x4 (&acc)[2][2][4][2], const pg8::Unit& u, int wr, int wc, int fr, int fq) const {
#pragma unroll
    for (int ai = 0; ai < 2; ++ai)
#pragma unroll
      for (int m = 0; m < 4; ++m) {
        const int row = u.pm * 256 + ai * 128 + wr * 64 + m * 16 + fr;
#pragma unroll
        for (int bj = 0; bj < 2; ++bj)
#pragma unroll
          for (int n = 0; n < 2; ++n) {
            const int col = u.pn * 256 + bj * 128 + wc * 32 + n * 16 + 4 * fq;
            const f32x4 a = acc[ai][bj][m][n];
            if (col < 3072) {
              u32x2 o = {cvtpk(a[0], a[1]), cvtpk(a[2], a[3])};
              *(u32x2*)(U + (size_t)row * 3072 + col) = o;
            } else if (col < 3088) {
              f32x4 o;
#pragma unroll
              for (int j = 0; j < 4; ++j) o[j] = softplusf(a[j] + dtb[col - 3072 + j]);
              *(f32x4*)(DT + (size_t)row * 16 + col - 3072) = o;
            }
          }
      }
  }
};
struct Epi8Bf {
  static constexpr bool PERM = false, AFTER_DRAIN = false;
  bf16_t* U; int ld;
  __device__ __forceinline__ void operator()(const f32x4 (&acc)[2][2][4][2], const pg8::Unit& u, int wr, int wc, int fr, int fq) const {
#pragma unroll
    for (int ai = 0; ai < 2; ++ai)
#pragma unroll
      for (int m = 0; m < 4; ++m) {
        const int row = u.pm * 256 + ai * 128 + wr * 64 + m * 16 + fr;
#pragma unroll
        for (int bj = 0; bj < 2; ++bj)
#pragma unroll
          for (int n = 0; n < 2; ++n) {
            const int col = u.pn * 256 + bj * 128 + wc * 32 + n * 16 + 4 * fq;
            const f32x4 a = acc[ai][bj][m][n];
            u32x2 o = {cvtpk(a[0], a[1]), cvtpk(a[2], a[3])};
            *(u32x2*)(U + (size_t)row * ld + col) = o;
          }
      }
  }
};
template <class Epi>
__device__ __forceinline__ void gemm8(const bf16_t* A, const bf16_t* Bt, int M, int N, int K, const Epi& E, char* smem, int ld = 0, int rot = 0) {
  const int G = (int)gridDim.x;
  pg8::StaticOrder S; S.init(M, N, G, ((int)blockIdx.x + G - rot % G) % G);
  pg8::Gemm g{A, Bt, M, N, K, ld ? ld : K};
  pg8::gemm_phase<Epi, pg8::StaticOrder, false>((PG8_LAS unsigned char*)smem, g, S, E, nullptr);
  __syncthreads();
}
struct Epi8Part {
  static constexpr bool PERM = false, AFTER_DRAIN = false;
  float* P; const float* modl; int gate; float scale;
  __device__ __forceinline__ void operator()(const f32x4 (&acc)[2][2][4][2], const pg8::Unit& u, int wr, int wc, int fr, int fq) const {
    const float* mrow = modl + (size_t)4 * 9216 + gate * 1024;
#pragma unroll
    for (int ai = 0; ai < 2; ++ai)
#pragma unroll
      for (int m = 0; m < 4; ++m) {
        const int row = u.pm * 256 + ai * 128 + wr * 64 + m * 16 + fr;
#pragma unroll
        for (int bj = 0; bj < 2; ++bj)
#pragma unroll
          for (int n = 0; n < 2; ++n) {
            const int col = u.pn * 256 + bj * 128 + wc * 32 + n * 16 + 4 * fq;
            const f32x4 mv = *(const f32x4*)(mrow + col);
            f32x4 o;
#pragma unroll
            for (int j = 0; j < 4; ++j) o[j] = scale * mv[j] * acc[ai][bj][m][n][j];
            *(f32x4*)(P + (size_t)row * DM + col) = o;
          }
      }
  }
};
__device__ __forceinline__ void ffn_down_phase(const Params& p, const bf16_t* G, const bf16_t* W, const float* modl, int gate, bool from_input, bool with_ctx, char* smem) {
  gemm8(G, W, TL, DM, DFF, Epi8Res{p, modl, gate, 0.5f, from_input}, smem);
  if (with_ctx) {
    float* P = (float*)(WSP(p) + OFF_PART);
    gemm8(G + (size_t)TL * DFF, W, TC, DM, 1408, Epi8Part{P, modl, gate, 0.5f}, smem, DFF, 0);
    gemm8(G + (size_t)TL * DFF + 1408, W + 1408, TC, DM, 1408, Epi8Part{P + (size_t)TC * DM, modl, gate, 0.5f}, smem, DFF, 16);
  }
}
__device__ __forceinline__ void phase_mixprep(const Params& p, int layer) {
  bf16_t* U = (bf16_t*)(WSP(p) + OFF_BIG);
  const int ld = layer == 0 ? 3072 : 2560;
  const int qcol0 = layer == 0 ? 0 : 1024;
  const float* qg = layer == 0 ? PRM(p, na_q_g) : PRM(p, diff_q_g);
  const float* kg = layer == 0 ? PRM(p, na_k_g) : PRM(p, diff_k_g);
  const int gtid = blockIdx.x * NT + tidx(), gsz = gridDim.x * NT;
  for (int it = gtid; it < TT * 128; it += gsz) {
    const int row = it >> 7, e = it & 127, grp = e >> 3, sub = e & 7;
    bf16_t* ptr = U + (size_t)row * ld + qcol0 + grp * 64 + sub * 8;
    const u32x4 v = *(const u32x4*)ptr;
    float f[8] = {bflo(v.x), bfhi(v.x), bflo(v.y), bfhi(v.y), bflo(v.z), bfhi(v.z), bflo(v.w), bfhi(v.w)};
    float ss = 0.f;
#pragma unroll
    for (int j = 0; j < 8; ++j) ss += f[j] * f[j];
    ss += __shfl_xor(ss, 1); ss += __shfl_xor(ss, 2); ss += __shfl_xor(ss, 4);
    const float rstd = rsqrtf(ss * (1.f / 64.f) + EPS);
    const bool isq = grp < 8;
    const float* gp = (isq ? qg : kg) + sub * 8;
#pragma unroll
    for (int j = 0; j < 8; ++j) f[j] = f[j] * rstd * gp[j];
    if (layer == 1 && row < TL) {
      const int t = row & 8191, gr = t >> 6, gc = t & 63;
      const float* rt = (const float*)(WSP(p) + OFF_ROPE);
#pragma unroll
      for (int j = 0; j < 4; ++j) {
        const int i = sub * 4 + j;
        const int pos = i < 16 ? gr : 128 + gc;
        const f32x2_t csn = *(const f32x2_t*)(rt + (pos * 16 + (i & 15)) * 2);
        const float x1 = f[2 * j], x2 = f[2 * j + 1];
        f[2 * j] = x1 * csn[0] - x2 * csn[1]; f[2 * j + 1] = x1 * csn[1] + x2 * csn[0];
      }
    }
    if (isq) {
#pragma unroll
      for (int j = 0; j < 8; ++j) f[j] *= 0.125f * LOG2E;
    }
    u32x4 o = {cvtpk(f[0], f[1]), cvtpk(f[2], f[3]), cvtpk(f[4], f[5]), cvtpk(f[6], f[7])};
    *(u32x4*)ptr = o;
    if (layer == 0) {
      bf16_t* XBC = (bf16_t*)(WSP(p) + OFF_XBC);
      const int c0 = e * 8;
      int t, len;
      if (row < TL) { t = row & 8191; len = 8192; } else { t = (row - TL) & 255; len = 256; }
      float a[8];
#pragma unroll
      for (int j = 0; j < 8; ++j) a[j] = PRM(p, ssd_conv_b)[c0 + j];
#pragma unroll
      for (int k = 0; k < 4; ++k) {
        const int tt = t + k - 2;
        if (tt >= 0 && tt < len) {
          const u32x4 v = *(const u32x4*)(U + (size_t)(row + k - 2) * 3072 + 2048 + c0);
          const float* wk = PRM(p, ssd_conv_w) + k * 1024 + c0;
          a[0] += wk[0] * bflo(v.x); a[1] += wk[1] * bfhi(v.x); a[2] += wk[2] * bflo(v.y); a[3] += wk[3] * bfhi(v.y);
          a[4] += wk[4] * bflo(v.z); a[5] += wk[5] * bfhi(v.z); a[6] += wk[6] * bflo(v.w); a[7] += wk[7] * bfhi(v.w);
        }
      }
#pragma unroll
      for (int j = 0; j < 8; ++j) a[j] = siluf(a[j]);
      u32x4 oc = {cvtpk(a[0], a[1]), cvtpk(a[2], a[3]), cvtpk(a[4], a[5]), cvtpk(a[6], a[7])};
      *(u32x4*)(XBC + (size_t)row * 1024 + c0) = oc;
    }
  }
}


constexpr int NKEYS = 8448;
__device__ __forceinline__ void phase_vt(const Params& p, char* smem) {
  const bf16_t* U = (const bf16_t*)(WSP(p) + OFF_BIG);
  bf16_t* VT = (bf16_t*)(WSP(p) + OFF_XBC);
  const int tid = tidx();
  for (int u = blockIdx.x; u < 16 * 132; u += gridDim.x) {
    const int bh = u / 132, kt = u - bh * 132, b = bh >> 2, head = bh & 3;
    const int ktok = kt < 4 ? TL + b * 256 + kt * 64 : b * 8192 + (kt - 4) * 64;
    __syncthreads();
    stage_T<false>(U + (size_t)ktok * 2560 + 2048 + head * 128, 2560, 64, 128, smem, 136, nullptr);
    __syncthreads();
    for (int idx = tid; idx < 2048; idx += NT) {
      const int dv = idx >> 4, g = idx & 15, st = g >> 2, gi = g & 3, pos = st * 4 + ((gi & 1) * 2 + (gi >> 1));
      const u32x2 v = *(const u32x2*)(smem + dv * 136 + g * 8);
      *(u32x2*)(VT + ((size_t)(bh * 128 + dv)) * NKEYS + kt * 64 + pos * 4) = v;
    }
  }
  __syncthreads();
}
__device__ __forceinline__ void na_unit(const Params& p, int b, int qtok0, int hq, int grow, char* smem) {
  const int tid = tidx(), lane = tid & 63, w = tid >> 6, hl = w >> 1, half = w & 1, l31 = lane & 31, h = lane >> 5;
  const bf16_t* U = (const bf16_t*)(WSP(p) + OFF_BIG);
  bf16_t* H = (bf16_t*)(WSP(p) + OFF_H);
  char* Ks = smem;
  char* Vt = smem + 36864;
  float* rp = (float*)(smem + 36864 + 34816);
  const float Mb = ((const float*)(WSP(p) + OFF_SCAL))[0];
  const int head = hq * 4 + hl;
  const int qtok = qtok0 + half * 32 + l31;
  bf16x8 qf[4];
#pragma unroll
  for (int s = 0; s < 4; ++s) qf[s] = *(const bf16x8*)(U + (size_t)qtok * 3072 + head * 64 + s * 16 + h * 8);
  f32x16 o0, o1;
#pragma unroll
  for (int i = 0; i < 16; ++i) { o0[i] = 0.f; o1[i] = 0.f; }
  float lsum = 0.f;
  const bool lat = grow >= 0;
  int r0 = 0;
  if (lat) {
    r0 = min(max(grow - 4, 0), 120);
    for (int i = tid; i < 4 * 465; i += NT) rp[i] = PRM(p, na_rpb)[(size_t)hq * 4 * 465 + i] * LOG2E;
  }
  const int cq = half * 32 + l31;
  unsigned mbits = 0;
  {
    const int qc0 = min(max(cq - 8, 0), 48);
#pragma unroll
    for (int kb = 0; kb < 2; ++kb)
#pragma unroll
      for (int i = 0; i < 16; ++i) {
        const int kc = kb * 32 + (i & 3) + 8 * (i >> 2) + 4 * h;
        if (kc >= qc0 && kc < qc0 + 16) mbits |= 1u << (kb * 16 + i);
      }
  }
  const int boff = 4 * h - cq + 15;
  u32x4 rk[4]; u32x2 rv[2][4];
  auto gload = [&](int kt) {
    const int ktok0 = kt < 8 ? b * 8192 + (r0 + kt) * 64 : TL + b * 256 + (kt - 8) * 64;
#pragma unroll
    for (int i = 0; i < 4; ++i) {
      const int c = tid + i * NT, key = c >> 5, hh = (c >> 3) & 3, kc = c & 7;
      rk[i] = *(const u32x4*)(U + (size_t)(ktok0 + key) * 3072 + 512 + hq * 256 + hh * 64 + kc * 8);
    }
#pragma unroll
    for (int j = 0; j < 2; ++j) {
      const int m = tid + j * NT, tc = m & 63, tt = m >> 6;
      const bf16_t* sp = U + (size_t)(ktok0 + tt * 4) * 3072 + 1024 + hq * 256 + tc * 4;
      rv[j][0] = *(const u32x2*)sp; rv[j][1] = *(const u32x2*)(sp + 3072); rv[j][2] = *(const u32x2*)(sp + 2 * 3072); rv[j][3] = *(const u32x2*)(sp + 3 * 3072);
    }
  };
  auto lstore = [&]() {
#pragma unroll
    for (int i = 0; i < 4; ++i) {
      const int c = tid + i * NT, key = c >> 5, hh = (c >> 3) & 3, kc = c & 7;
      *(u32x4*)(Ks + hh * 9216 + key * 144 + kc * 16) = rk[i];
    }
#pragma unroll
    for (int j = 0; j < 2; ++j) {
      const int m = tid + j * NT, tc = m & 63, tt = m >> 6;
      const u32x2 v0 = rv[j][0], v1 = rv[j][1], v2 = rv[j][2], v3 = rv[j][3];
      u32x2 o0, o1, o2, o3;
      o0.x = (v0.x & 0xffffu) | (v1.x << 16); o0.y = (v2.x & 0xffffu) | (v3.x << 16);
      o1.x = (v0.x >> 16) | (v1.x & 0xffff0000u); o1.y = (v2.x >> 16) | (v3.x & 0xffff0000u);
      o2.x = (v0.y & 0xffffu) | (v1.y << 16); o2.y = (v2.y & 0xffffu) | (v3.y << 16);
      o3.x = (v0.y >> 16) | (v1.y & 0xffff0000u); o3.y = (v2.y >> 16) | (v3.y & 0xffff0000u);
      char* d = Vt + (size_t)(tc * 4) * 136 + tt * 8;
      *(u32x2*)d = o0; *(u32x2*)(d + 136) = o1; *(u32x2*)(d + 272) = o2; *(u32x2*)(d + 408) = o3;
    }
  };
  gload(lat ? 0 : 8);
  for (int kt = lat ? 0 : 8; kt < 12; ++kt) {
    __syncthreads();
    lstore();
    __syncthreads();
    if (kt + 1 < 12) gload(kt + 1);
    const int dr = r0 + kt - grow + 7;
    unsigned mb = mbits;
    asm volatile("" : "+v"(mb));
    const float* pb = rp + hl * 465 + dr * 31 + boff;
#pragma unroll
    for (int kb = 0; kb < 2; ++kb) {
      f32x16 s;
#pragma unroll
      for (int i = 0; i < 16; ++i) s[i] = -Mb;
#pragma unroll
      for (int sp = 0; sp < 4; ++sp) s = mfma32(ldsfrag16(Ks + hl * 9216 + (kb * 32 + l31) * 144 + sp * 32 + h * 16), qf[sp], s);
      float pv[16];
      if (kt < 8) {
#pragma unroll
        for (int i = 0; i < 16; ++i) {
          const float e = __builtin_amdgcn_exp2f(s[i] + pb[kb * 32 + (i & 3) + 8 * (i >> 2)]);
          pv[i] = __uint_as_float(__float_as_uint(e) & (unsigned)__builtin_amdgcn_sbfe((int)mb, kb * 16 + i, 1));
          lsum += pv[i];
        }
      } else {
#pragma unroll
        for (int i = 0; i < 16; ++i) { pv[i] = __builtin_amdgcn_exp2f(s[i]); lsum += pv[i]; }
      }
#pragma unroll
      for (int ss = 0; ss < 2; ++ss) {
        u32x4 pk = {cvtpk(pv[8 * ss], pv[8 * ss + 1]), cvtpk(pv[8 * ss + 2], pv[8 * ss + 3]), cvtpk(pv[8 * ss + 4], pv[8 * ss + 5]), cvtpk(pv[8 * ss + 6], pv[8 * ss + 7])};
        const bf16x8 pf = __builtin_bit_cast(bf16x8, pk);
        const char* vb = Vt + (size_t)(hl * 64 + l31) * 136 + (kb * 32 + ss * 16 + 4 * h) * 2;
        o0 = mfma32(ldsfrag8x2(vb, vb + 16), pf, o0);
        o1 = mfma32(ldsfrag8x2(vb + 32 * 136, vb + 32 * 136 + 16), pf, o1);
      }
    }
  }
  lsum += __shfl_xor(lsum, 32);
  float inv = 1.f / lsum;
#ifdef NA_ZERO
  inv = 0.f * (lsum > 0.f ? 1.f : 0.f); for (int i = 0; i < 16; ++i) { o0[i] = 1.f; o1[i] = 1.f; }
#endif
  bf16_t* hp = H + (size_t)qtok * DM + head * 64;
#pragma unroll
  for (int g = 0; g < 4; ++g) {
    u32x2 a = {cvtpk(o0[4 * g] * inv, o0[4 * g + 1] * inv), cvtpk(o0[4 * g + 2] * inv, o0[4 * g + 3] * inv)};
    u32x2 c = {cvtpk(o1[4 * g] * inv, o1[4 * g + 1] * inv), cvtpk(o1[4 * g + 2] * inv, o1[4 * g + 3] * inv)};
    *(u32x2*)(hp + 8 * g + 4 * h) = a;
    *(u32x2*)(hp + 32 + 8 * g + 4 * h) = c;
  }
  __syncthreads();
}

__device__ __forceinline__ void wave_cumsum2(float v0, float v1, float& c0, float& c1, float& tot, int lane) {
  float s = v0 + v1;
#pragma unroll
  for (int o = 1; o < 64; o <<= 1) { const float t = __shfl_up(s, o); if (lane >= o) s += t; }
  c1 = s; c0 = s - v1; tot = __int_as_float(__builtin_amdgcn_readlane(__float_as_int(s), 63));
}
__device__ __forceinline__ void ssdA_unit(const Params& p, int b, int cc, int head, char* smem) {
  const int tid = tidx(), lane = tid & 63, w = tid >> 6, l31 = lane & 31, h = lane >> 5;
  const int tok0 = chunk_tok0(b, cc), g = head >> 2;
  const bf16_t* XBC = (const bf16_t*)(WSP(p) + OFF_XBC);
  const float* DT = (const float*)(WSP(p) + OFF_DT);
  char* BT = smem;
  char* XWT = smem + 34816;
  float* wl = (float*)(smem + 69632);
  if (w < 2) {
    const int dir = w;
    const float d0 = DT[(size_t)(tok0 + 2 * lane) * 16 + dir * 8 + head], d1 = DT[(size_t)(tok0 + 2 * lane + 1) * 16 + dir * 8 + head];
    const float Aa = -expf(PRM(p, ssd_a_log)[dir * 8 + head]);
    const float v0 = d0 * Aa, v1 = d1 * Aa;
    float c0, c1, tot;
    wave_cumsum2(v0, v1, c0, c1, tot, lane);
    if (dir == 0) { wl[2 * lane] = expf(tot - c0) * d0; wl[2 * lane + 1] = expf(tot - c1) * d1; }
    else { wl[128 + 2 * lane] = expf(c0 - v0) * d0; wl[128 + 2 * lane + 1] = expf(c1 - v1) * d1; }
    if (lane == 0) ((float*)(WSP(p) + OFF_DEC))[((b * 2 + dir) * 8 + head) * 66 + cc] = expf(tot);
  }
  __syncthreads();
  stage_T<false>(XBC + (size_t)tok0 * 1024 + 512 + g * 128, 1024, 128, 128, BT, 272, nullptr);
  stage_T<true>(XBC + (size_t)tok0 * 1024 + head * 64, 1024, 128, 64, XWT, 272, wl);
  stage_T<true>(XBC + (size_t)tok0 * 1024 + head * 64, 1024, 128, 64, XWT + 17408, 272, wl + 128);
  __syncthreads();
  {
    const int dir = w >> 2, nb = w & 3;
    f32x16 a0, a1;
#pragma unroll
    for (int i = 0; i < 16; ++i) { a0[i] = 0.f; a1[i] = 0.f; }
    const char* xb = XWT + dir * 17408;
#pragma unroll
    for (int ks = 0; ks < 8; ++ks) {
      const bf16x8 bt = ldsfrag16(BT + (nb * 32 + l31) * 272 + ks * 32 + h * 16);
      a0 = mfma32(bt, ldsfrag16(xb + l31 * 272 + ks * 32 + h * 16), a0);
      a1 = mfma32(bt, ldsfrag16(xb + (32 + l31) * 272 + ks * 32 + h * 16), a1);
    }
    bf16_t* st = (bf16_t*)(WSP(p) + OFF_ST) + ((size_t)(((b * 2 + dir) * 8 + head) * 66 + cc)) * 8192;
#pragma unroll
    for (int gg = 0; gg < 4; ++gg) {
      const int n = nb * 32 + 8 * gg + 4 * h;
      u32x2 x0 = {cvtpk(a0[4 * gg], a0[4 * gg + 1]), cvtpk(a0[4 * gg + 2], a0[4 * gg + 3])};
      u32x2 x1 = {cvtpk(a1[4 * gg], a1[4 * gg + 1]), cvtpk(a1[4 * gg + 2], a1[4 * gg + 3])};
      *(u32x2*)(st + (size_t)l31 * 128 + n) = x0;
      *(u32x2*)(st + (size_t)(32 + l31) * 128 + n) = x1;
    }
  }
  __syncthreads();
}
__device__ __forceinline__ int scan_order(int dir, int s) { return dir == 0 ? s : (s == 0 ? 1 : (s == 1 ? 0 : 67 - s)); }
__device__ __forceinline__ void phase_ssdB(const Params& p) {
  const int gtid = blockIdx.x * NT + tidx(), gsz = gridDim.x * NT;
  bf16_t* ST = (bf16_t*)(WSP(p) + OFF_ST);
  const float* DEC = (const float*)(WSP(p) + OFF_DEC);
  for (int item = gtid; item < 64 * 2048; item += gsz) {
    const int combo = item >> 11, e = (item & 2047) * 4;
    const int dir = (combo >> 3) & 1;
    bf16_t* base = ST + (size_t)combo * 66 * 8192 + e;
    const float* dec = DEC + combo * 66;
    float h0 = 0.f, h1 = 0.f, h2 = 0.f, h3 = 0.f;
    for (int s0 = 0; s0 < 66; s0 += 11) {
      u32x2 v[11]; float d[11];
#pragma unroll
      for (int q = 0; q < 11; ++q) { const int cc = scan_order(dir, s0 + q); v[q] = *(const u32x2*)(base + (size_t)cc * 8192); d[q] = dec[cc]; }
#pragma unroll
      for (int q = 0; q < 11; ++q) {
        const int cc = scan_order(dir, s0 + q);
        u32x2 o = {cvtpk(h0, h1), cvtpk(h2, h3)};
        *(u32x2*)(base + (size_t)cc * 8192) = o;
        h0 = h0 * d[q] + bflo(v[q].x); h1 = h1 * d[q] + bfhi(v[q].x); h2 = h2 * d[q] + bflo(v[q].y); h3 = h3 * d[q] + bfhi(v[q].y);
      }
    }
  }
}
__device__ __forceinline__ void ssdC_unit(const Params& p, int b, int cc, int head, char* smem) {
  const int tid = tidx(), lane = tid & 63, w = tid >> 6, l31 = lane & 31, h = lane >> 5;
  const int tok0 = chunk_tok0(b, cc), g = head >> 2;
  const bf16_t* XBC = (const bf16_t*)(WSP(p) + OFF_XBC);
  const bf16_t* U = (const bf16_t*)(WSP(p) + OFF_BIG);
  const float* DT = (const float*)(WSP(p) + OFF_DT);
  bf16_t* H = (bf16_t*)(WSP(p) + OFF_H);
  char* Cn = smem;
  char* Bn = smem + 34816;
  char* XT = smem + 69632;
  char* Hf = smem + 87040;
  char* Hb = smem + 104448;
  float* vec = (float*)(smem + 121856);
  if (w < 2) {
    const int dir = w;
    const float d0 = DT[(size_t)(tok0 + 2 * lane) * 16 + dir * 8 + head], d1 = DT[(size_t)(tok0 + 2 * lane + 1) * 16 + dir * 8 + head];
    const float Aa = -expf(PRM(p, ssd_a_log)[dir * 8 + head]);
    const float v0 = d0 * Aa, v1 = d1 * Aa;
    float c0, c1, tot;
    wave_cumsum2(v0, v1, c0, c1, tot, lane);
    if (dir == 0) {
      vec[2 * lane] = c0; vec[2 * lane + 1] = c1; vec[256 + 2 * lane] = d0; vec[256 + 2 * lane + 1] = d1;
      vec[512 + 2 * lane] = expf(c0); vec[512 + 2 * lane + 1] = expf(c1);
    } else {
      vec[128 + 2 * lane] = c0 - v0; vec[128 + 2 * lane + 1] = c1 - v1; vec[384 + 2 * lane] = d0; vec[384 + 2 * lane + 1] = d1;
      vec[640 + 2 * lane] = expf(tot - (c0 - v0)); vec[640 + 2 * lane + 1] = expf(tot - (c1 - v1));
    }
  }
  stage_N(XBC + (size_t)tok0 * 1024 + 768 + g * 128, 1024, 128, 256, Cn, 272);
  stage_N(XBC + (size_t)tok0 * 1024 + 512 + g * 128, 1024, 128, 256, Bn, 272);
  stage_T<false>(XBC + (size_t)tok0 * 1024 + head * 64, 1024, 128, 64, XT, 272, nullptr);
  const bf16_t* ST = (const bf16_t*)(WSP(p) + OFF_ST);
  stage_N(ST + ((size_t)(((b * 2 + 0) * 8 + head) * 66 + cc)) * 8192, 128, 64, 256, Hf, 272);
  stage_N(ST + ((size_t)(((b * 2 + 1) * 8 + head) * 66 + cc)) * 8192, 128, 64, 256, Hb, 272);
  __syncthreads();
  const float* csf = vec; const float* exb = vec + 128; const float* dtf = vec + 256; const float* dtb = vec + 384;
  const float* ef = vec + 512; const float* eb = vec + 640;
  {
    const int ib = w & 3, jb0 = (w >> 2) * 2;
    f32x16 c0, c1;
#pragma unroll
    for (int i = 0; i < 16; ++i) { c0[i] = 0.f; c1[i] = 0.f; }
#pragma unroll
    for (int ks = 0; ks < 8; ++ks) {
      const bf16x8 cf = ldsfrag16(Cn + (ib * 32 + l31) * 272 + ks * 32 + h * 16);
      c0 = mfma32(ldsfrag16(Bn + (jb0 * 32 + l31) * 272 + ks * 32 + h * 16), cf, c0);
      c1 = mfma32(ldsfrag16(Bn + ((jb0 + 1) * 32 + l31) * 272 + ks * 32 + h * 16), cf, c1);
    }
    __syncthreads();
    const int i = ib * 32 + l31;
    const float csi = csf[i], exi = exb[i];
#pragma unroll
    for (int jj = 0; jj < 2; ++jj) {
#pragma unroll
      for (int gg = 0; gg < 4; ++gg) {
        const int j0 = (jb0 + jj) * 32 + 8 * gg + 4 * h;
        float m[4];
#pragma unroll
        for (int x = 0; x < 4; ++x) {
          const int j = j0 + x;
          const float cb = jj == 0 ? c0[4 * gg + x] : c1[4 * gg + x];
          float fv = 0.f;
          if (j <= i) fv += __expf(csi - csf[j]) * dtf[j];
          if (j >= i) fv += __expf(exb[j] - exi) * dtb[j];
          m[x] = cb * fv;
        }
        u32x2 o = {cvtpk(m[0], m[1]), cvtpk(m[2], m[3])};
        *(u32x2*)(Bn + i * 272 + j0 * 2) = o;
      }
    }
  }
  __syncthreads();
  {
    const int pb = w >> 2, ib = w & 3;
    f32x16 yd, yf, yb;
#pragma unroll
    for (int i = 0; i < 16; ++i) { yd[i] = 0.f; yf[i] = 0.f; yb[i] = 0.f; }
#pragma unroll
    for (int ks = 0; ks < 8; ++ks) {
      yd = mfma32(ldsfrag16(XT + (pb * 32 + l31) * 272 + ks * 32 + h * 16), ldsfrag16(Bn + (ib * 32 + l31) * 272 + ks * 32 + h * 16), yd);
      const bf16x8 cf = ldsfrag16(Cn + (ib * 32 + l31) * 272 + ks * 32 + h * 16);
      yf = mfma32(ldsfrag16(Hf + (pb * 32 + l31) * 272 + ks * 32 + h * 16), cf, yf);
      yb = mfma32(ldsfrag16(Hb + (pb * 32 + l31) * 272 + ks * 32 + h * 16), cf, yb);
    }
    const int i = ib * 32 + l31, tok = tok0 + i;
    const float e_f = ef[i], e_b = eb[i], Dk = PRM(p, ssd_d)[head];
    float ssq = 0.f;
#pragma unroll
    for (int gg = 0; gg < 4; ++gg) {
      const int p0 = pb * 32 + 8 * gg + 4 * h;
      const u32x2 xv = *(const u32x2*)(XBC + (size_t)tok * 1024 + head * 64 + p0);
      const u32x2 zv = *(const u32x2*)(U + (size_t)tok * 3072 + 1536 + head * 64 + p0);
      const float xs[4] = {bflo(xv.x), bfhi(xv.x), bflo(xv.y), bfhi(xv.y)};
      const float zs[4] = {bflo(zv.x), bfhi(zv.x), bflo(zv.y), bfhi(zv.y)};
      float gv[4];
#pragma unroll
      for (int x = 0; x < 4; ++x) {
        const float y = yd[4 * gg + x] + e_f * yf[4 * gg + x] + e_b * yb[4 * gg + x] + Dk * xs[x];
        gv[x] = y * siluf(zs[x]);
        ssq += gv[x] * gv[x];
      }
      u32x2 o = {cvtpk(gv[0], gv[1]), cvtpk(gv[2], gv[3])};
      *(u32x2*)(H + (size_t)tok * DM + 512 + head * 64 + p0) = o;
    }
    ssq += __shfl_xor(ssq, 32);
    if (h == 0) ((float*)(WSP(p) + OFF_SSQ))[(size_t)tok * 16 + head * 2 + pb] = ssq;
  }
  __syncthreads();
}

__device__ __forceinline__ void lru_unit(const Params& p, int b, int cc, int nb, int mode, char* smem) {
  const int tid = tidx(), lane = tid & 63, w = tid >> 6, l31 = lane & 31, h = lane >> 5;
  const int tok0 = chunk_tok0(b, cc);
  const bf16_t* U = (const bf16_t*)(WSP(p) + OFF_BIG);
  float* xf = (float*)smem;
  float* aL = (float*)(smem + 34816);
  bf16_t* bL = (bf16_t*)(smem + 100352);
  float* segA = (float*)(smem + 133120);
  float* segH = segA + 1024;
  float* segS = segH + 1024;
  const int c = tid & 63, seg = tid >> 6;
  float gt[16];
  if (mode == 1) {
#pragma unroll
    for (int k = 0; k < 16; ++k) gt[k] = bflo((unsigned)U[(size_t)(tok0 + seg * 16 + k) * 2560 + nb * 64 + c]);
  }
  {
    const int t = tid >> 2, c0 = (tid & 3) * 16;
    int tseq, len;
    if (cc < 2) { tseq = cc * 128 + t; len = 256; } else { tseq = (cc - 2) * 128 + t; len = 8192; }
    float a[16];
#pragma unroll
    for (int jx = 0; jx < 16; ++jx) a[jx] = PRM(p, lru_conv_b)[nb * 64 + c0 + jx];
#pragma unroll
    for (int k = 0; k < 4; ++k) {
      const int ts = tseq + k - 2;
      if (ts >= 0 && ts < len) {
        const bf16_t* sp = U + (size_t)(tok0 + t + k - 2) * 2560 + 512 + nb * 64 + c0;
        const u32x4 v0 = *(const u32x4*)sp, v1 = *(const u32x4*)(sp + 8);
        const float* wk = PRM(p, lru_conv_w) + k * 512 + nb * 64 + c0;
        a[0] += wk[0] * bflo(v0.x); a[1] += wk[1] * bfhi(v0.x); a[2] += wk[2] * bflo(v0.y); a[3] += wk[3] * bfhi(v0.y);
        a[4] += wk[4] * bflo(v0.z); a[5] += wk[5] * bfhi(v0.z); a[6] += wk[6] * bflo(v0.w); a[7] += wk[7] * bfhi(v0.w);
        a[8] += wk[8] * bflo(v1.x); a[9] += wk[9] * bfhi(v1.x); a[10] += wk[10] * bflo(v1.y); a[11] += wk[11] * bfhi(v1.y);
        a[12] += wk[12] * bflo(v1.z); a[13] += wk[13] * bfhi(v1.z); a[14] += wk[14] * bflo(v1.w); a[15] += wk[15] * bfhi(v1.w);
      }
    }
#pragma unroll
    for (int jx = 0; jx < 16; ++jx) xf[t * 68 + c0 + jx] = a[jx];
  }
  __syncthreads();
  const bf16_t* WL = (const bf16_t*)(WSP(p) + OFF_WLRU);
  {
    const int tb = w >> 1, eb = w & 1, e = eb * 32 + l31, ch = nb * 64 + e;
    bf16x8 xa[4];
#pragma unroll
    for (int s4 = 0; s4 < 4; ++s4) {
      const float* xp = xf + (tb * 32 + l31) * 68 + s4 * 16 + h * 8;
      const f32x4 x0 = *(const f32x4*)xp, x1 = *(const f32x4*)(xp + 4);
      u32x4 pk = {cvtpk(x0[0], x0[1]), cvtpk(x0[2], x0[3]), cvtpk(x1[0], x1[1]), cvtpk(x1[2], x1[3])};
      xa[s4] = __builtin_bit_cast(bf16x8, pk);
    }
#pragma unroll 1
    for (int dir = 0; dir < 2; ++dir) {
      f32x16 ra, ia;
#pragma unroll
      for (int i = 0; i < 16; ++i) { ra[i] = 0.f; ia[i] = 0.f; }
      const bf16_t* wa = WL + ((size_t)((0 * 2 + dir) * 8 + nb)) * 4096 + e * 64;
      const bf16_t* wx = WL + ((size_t)((1 * 2 + dir) * 8 + nb)) * 4096 + e * 64;
#pragma unroll
      for (int s4 = 0; s4 < 4; ++s4) {
        ra = mfma32(xa[s4], *(const bf16x8*)(wa + s4 * 16 + h * 8), ra);
        ia = mfma32(xa[s4], *(const bf16x8*)(wx + s4 * 16 + h * 8), ia);
      }
      const float ba = PRM(p, lru_ba)[dir * 512 + ch], bx = PRM(p, lru_bx)[dir * 512 + ch];
      const float sp = softplusf(-PRM(p, lru_lambda)[dir * 512 + ch]);
#pragma unroll
      for (int i = 0; i < 16; ++i) {
        const int t = tb * 32 + (i & 3) + 8 * (i >> 2) + 4 * h;
        const float rg = sigmf(ra[i] + ba), ig = sigmf(ia[i] + bx);
        const float la = -8.f * rg * sp;
        const float av = __expf(la);
        const float bv = __builtin_amdgcn_sqrtf(fmaxf(1.f - av * av, 0.f)) * ig * xf[t * 68 + e];
        aL[(dir * 128 + t) * 64 + e] = av;
        bL[(dir * 128 + t) * 64 + e] = (bf16_t)(cvtpk(bv, 0.f) & 0xffffu);
      }
    }
  }
  __syncthreads();
  {
    float A0 = 1.f, H0 = 0.f, A1 = 1.f, H1 = 0.f;
#pragma unroll
    for (int k = 0; k < 16; ++k) {
      const int t0 = seg * 16 + k, t1 = seg * 16 + 15 - k;
      const float a0 = aL[t0 * 64 + c], a1 = aL[(128 + t1) * 64 + c];
      H0 = a0 * H0 + bflo((unsigned)bL[t0 * 64 + c]); A0 *= a0;
      H1 = a1 * H1 + bflo((unsigned)bL[(128 + t1) * 64 + c]); A1 *= a1;
    }
    segA[seg * 64 + c] = A0; segH[seg * 64 + c] = H0;
    segA[512 + seg * 64 + c] = A1; segH[512 + seg * 64 + c] = H1;
  }
  __syncthreads();
  if (tid < 128) {
    const int dir = tid >> 6;
    const size_t cidx = ((size_t)((b * 2 + dir) * 66 + cc)) * 512 + nb * 64 + c;
    if (mode == 0) {
      float At = 1.f, Ht = 0.f;
#pragma unroll
      for (int q = 0; q < 8; ++q) { const int sg = dir == 0 ? q : 7 - q; Ht = segA[dir * 512 + sg * 64 + c] * Ht + segH[dir * 512 + sg * 64 + c]; At *= segA[dir * 512 + sg * 64 + c]; }
      ((float*)(WSP(p) + OFF_LCA))[cidx] = At; ((float*)(WSP(p) + OFF_LCH))[cidx] = Ht;
    } else {
      float hcur = ((const float*)(WSP(p) + OFF_LHIN))[cidx];
#pragma unroll
      for (int q = 0; q < 8; ++q) { const int sg = dir == 0 ? q : 7 - q; segS[dir * 512 + sg * 64 + c] = hcur; hcur = segA[dir * 512 + sg * 64 + c] * hcur + segH[dir * 512 + sg * 64 + c]; }
    }
  }
  if (mode == 1) {
    __syncthreads();
    float hf[16];
    float hc = segS[seg * 64 + c];
#pragma unroll
    for (int k = 0; k < 16; ++k) { const int t = seg * 16 + k; hc = aL[t * 64 + c] * hc + bflo((unsigned)bL[t * 64 + c]); hf[k] = hc; }
    hc = segS[512 + seg * 64 + c];
    bf16_t* hp = (bf16_t*)(WSP(p) + OFF_H) + (size_t)(tok0 + seg * 16) * DM + nb * 64 + c;
#pragma unroll
    for (int k = 15; k >= 0; --k) {
      const int t = seg * 16 + k;
      hc = aL[(128 + t) * 64 + c] * hc + bflo((unsigned)bL[(128 + t) * 64 + c]);
      hp[(size_t)k * DM] = (bf16_t)(cvtpk(gelu_tanh(gt[k]) * (hf[k] + hc), 0.f) & 0xffffu);
    }
  }
  __syncthreads();
}
__device__ __forceinline__ void phase_lruY(const Params& p) {
  const int gtid = blockIdx.x * NT + tidx();
  if (gtid < 4096) {
    const int ch = gtid & 511, bd = gtid >> 9, dir = bd & 1;
    const float* CA = (const float*)(WSP(p) + OFF_LCA) + (size_t)bd * 66 * 512 + ch;
    const float* CH = (const float*)(WSP(p) + OFF_LCH) + (size_t)bd * 66 * 512 + ch;
    float* HIN = (float*)(WSP(p) + OFF_LHIN) + (size_t)bd * 66 * 512 + ch;
    float hcur = 0.f;
    for (int s0 = 0; s0 < 66; s0 += 11) {
      float a[11], hh[11];
#pragma unroll
      for (int q = 0; q < 11; ++q) { const int cc = scan_order(dir, s0 + q); a[q] = CA[cc * 512]; hh[q] = CH[cc * 512]; }
#pragma unroll
      for (int q = 0; q < 11; ++q) { const int cc = scan_order(dir, s0 + q); HIN[cc * 512] = hcur; hcur = a[q] * hcur + hh[q]; }
    }
  }
}

__device__ __forceinline__ void diff_unit(const Params& p, int b, int head, int qb, char* smem) {
  const int tid = tidx(), lane = tid & 63, w = __builtin_amdgcn_readfirstlane(tid >> 6), l31 = lane & 31, h = lane >> 5, grp = w >> 1, t = w & 1;
  const bf16_t* U = (const bf16_t*)(WSP(p) + OFF_BIG);
  const bf16_t* VT = (const bf16_t*)(WSP(p) + OFF_XBC) + (size_t)((b * 4 + head) * 128) * NKEYS;
  const float* sc = (const float*)(WSP(p) + OFF_SCAL);
  const float Mb = sc[1], lam = sc[2];
  const int qtok = b * 8192 + qb * 256 + grp * 64 + l31;
  char* Qs = smem;
  char* stg = smem + 69632;
  stage_N(U + (size_t)(b * 8192 + qb * 256) * 2560 + 1024 + head * 128, 2560, 256, 256, Qs, 272);
  const char* qrow = Qs + (grp * 64 + l31) * 272 + t * 128 + h * 16;
  f32x16 o[2][4];
#pragma unroll
  for (int qg = 0; qg < 2; ++qg)
#pragma unroll
    for (int d = 0; d < 4; ++d)
#pragma unroll
      for (int i = 0; i < 16; ++i) o[qg][d][i] = 0.f;
  float l0 = 0.f, l1 = 0.f;
  auto dma = [&](int kt, int buf) {
    const int ktk = kt < 4 ? TL + b * 256 + kt * 64 : b * 8192 + (kt - 4) * 64;
    const bf16_t* kb_ = U + (size_t)ktk * 2560;
    const bf16_t* vb_ = VT + kt * 64;
    char* Ks = stg + buf * 32768;
#pragma unroll
    for (int jx = 0; jx < 2; ++jx) {
      int tl = tid; asm volatile("" : "+v"(tl));
      const int L = jx * 512 + tl, key = L >> 4, c = (L & 15) ^ (key & 15);
      const unsigned koffj = (unsigned)(key * 2560 + 1536 + head * 128 + c * 8);
      const int dvv = L >> 3, cv = (L & 7) ^ ((dvv >> 1) & 7);
      const unsigned voffj = (unsigned)(dvv * NKEYS + cv * 8);
      __builtin_amdgcn_global_load_lds((const unsigned*)(kb_ + koffj), (PG8_LAS unsigned*)(Ks + (jx * 512 + w * 64) * 16), 16, 0, 0);
      __builtin_amdgcn_global_load_lds((const unsigned*)(vb_ + voffj), (PG8_LAS unsigned*)(Ks + 16384 + (jx * 512 + w * 64) * 16), 16, 0, 0);
    }
  };
  constexpr int NKT = 132;
  dma(0, 0);
  asm volatile("s_waitcnt vmcnt(0)" ::: "memory");
  __syncthreads();
  for (int kt = 0; kt < NKT; ++kt) {
    if (kt + 1 < NKT) dma(kt + 1, (kt + 1) & 1);
    const char* Ks = stg + (kt & 1) * 32768; const char* Vt = Ks + 16384;
#pragma unroll 1
    for (int kb = 0; kb < 2; ++kb) {
      f32x16 s0, s1;
#pragma unroll
      for (int i = 0; i < 16; ++i) { s0[i] = -Mb; s1[i] = -Mb; }
      const int key = kb * 32 + l31;
      __builtin_amdgcn_s_setprio(1);
#pragma unroll
      for (int sp = 0; sp < 4; ++sp) {
        const bf16x8 kf = ldsfrag16(Ks + key * 256 + (((t * 8 + sp * 2 + h) ^ (key & 15)) << 4));
        s0 = mfma32(kf, ldsfrag16(qrow + sp * 32), s0);
        s1 = mfma32(kf, ldsfrag16(qrow + 32 * 272 + sp * 32), s1);
      }
      __builtin_amdgcn_s_setprio(0);
      bf16x8 pf0[2], pf1[2];
#pragma unroll
      for (int i = 0; i < 16; ++i) { s0[i] = __builtin_amdgcn_exp2f(s0[i]); l0 += s0[i]; }
#pragma unroll
      for (int ss = 0; ss < 2; ++ss) {
        u32x4 pk = {cvtpk(s0[8 * ss], s0[8 * ss + 1]), cvtpk(s0[8 * ss + 2], s0[8 * ss + 3]), cvtpk(s0[8 * ss + 4], s0[8 * ss + 5]), cvtpk(s0[8 * ss + 6], s0[8 * ss + 7])};
        pf0[ss] = __builtin_bit_cast(bf16x8, pk);
      }
#pragma unroll
      for (int i = 0; i < 16; ++i) { s1[i] = __builtin_amdgcn_exp2f(s1[i]); l1 += s1[i]; }
#pragma unroll
      for (int ss = 0; ss < 2; ++ss) {
        u32x4 pk = {cvtpk(s1[8 * ss], s1[8 * ss + 1]), cvtpk(s1[8 * ss + 2], s1[8 * ss + 3]), cvtpk(s1[8 * ss + 4], s1[8 * ss + 5]), cvtpk(s1[8 * ss + 6], s1[8 * ss + 7])};
        pf1[ss] = __builtin_bit_cast(bf16x8, pk);
      }
      __builtin_amdgcn_sched_barrier(0);
      __builtin_amdgcn_s_setprio(1);
#pragma unroll
      for (int ss = 0; ss < 2; ++ss) {
#pragma unroll
        for (int d = 0; d < 4; ++d) {
          const int dv = d * 32 + l31;
          const bf16x8 vf = ldsfrag16(Vt + dv * 128 + ((((kb * 2 + ss) * 2 + h) ^ ((dv >> 1) & 7)) << 4));
          o[0][d] = mfma32(vf, pf0[ss], o[0][d]);
          o[1][d] = mfma32(vf, pf1[ss], o[1][d]);
        }
        __builtin_amdgcn_sched_barrier(0);
      }
      __builtin_amdgcn_s_setprio(0);
    }
    asm volatile("s_waitcnt vmcnt(0)" ::: "memory");
    __syncthreads();
  }
  l0 += __shfl_xor(l0, 32); l1 += __shfl_xor(l1, 32);
  float* ex = (float*)smem;
  if (t == 1) {
    const float c0 = lam / l0, c1 = lam / l1;
#pragma unroll
    for (int qg = 0; qg < 2; ++qg)
#pragma unroll
      for (int d = 0; d < 4; ++d) {
#pragma unroll
        for (int i = 0; i < 16; ++i) ex[(((grp * 2 + qg) * 4 + d) * 16 + i) * 64 + lane] = o[qg][d][i] * (qg == 0 ? c0 : c1);
        __builtin_amdgcn_sched_barrier(0);
      }
  }
  __syncthreads();
  if (t == 0) {
    const float* sgp = PRM(p, diff_subln_g);
#pragma unroll
    for (int qg = 0; qg < 2; ++qg) {
      const float i0 = 1.f / (qg == 0 ? l0 : l1);
      float ssq = 0.f;
#pragma unroll
      for (int d = 0; d < 4; ++d) {
#pragma unroll
        for (int i = 0; i < 16; ++i) { const float v = o[qg][d][i] * i0 - ex[(((grp * 2 + qg) * 4 + d) * 16 + i) * 64 + lane]; o[qg][d][i] = v; ssq += v * v; }
        __builtin_amdgcn_sched_barrier(0);
      }
      ssq += __shfl_xor(ssq, 32);
      const float rstd = rsqrtf(ssq * (1.f / 128.f) + EPS) * (1.f - LAM_INIT);
      bf16_t* hp = (bf16_t*)(WSP(p) + OFF_H) + (size_t)(qtok + qg * 32) * DM + 512 + head * 128;
#pragma unroll
      for (int d = 0; d < 4; ++d)
#pragma unroll
        for (int g = 0; g < 4; ++g) {
          const int dv = d * 32 + 8 * g + 4 * h;
          const f32x4 sg = *(const f32x4*)(sgp + dv);
          u32x2 ov = {cvtpk(o[qg][d][4 * g] * rstd * sg[0], o[qg][d][4 * g + 1] * rstd * sg[1]), cvtpk(o[qg][d][4 * g + 2] * rstd * sg[2], o[qg][d][4 * g + 3] * rstd * sg[3])};
          *(u32x2*)(hp + dv) = ov;
          __builtin_amdgcn_sched_barrier(0);
        }
    }
  }
  __syncthreads();
}

constexpr int NPHASE = 28;
#ifndef PHMASK
#define PHMASK 0xffff
#endif
#define EN(k) (((PHMASK) >> (k)) & 1)
__device__ __forceinline__ void grid_barrier(unsigned* bar, unsigned epoch);
__device__ __forceinline__ void run_phase(const Params& p, int ph, char* smem, unsigned* bar, unsigned& nbar, bool rep) {
  bf16_t* H = (bf16_t*)(WSP(p) + OFF_H);
  bf16_t* BIG = (bf16_t*)(WSP(p) + OFF_BIG);
  if (ph == 0) { if (EN(0)) phase_prep(p, smem, rep ? PROBE_SUB : 0); return; }
  if (ph == 1) {
    { const int gt = blockIdx.x * NT + tidx(); float* xc = (float*)(WSP(p) + OFF_XC); const float* cin = PRM(p, ctx);
      for (int i = gt; i < TC * DM / 4; i += gridDim.x * NT) *(f32x4*)(xc + (size_t)i * 4) = *(const f32x4*)(cin + (size_t)i * 4); }
    phase_modreduce(p); convert_weights(p, smem, 1, (int)blockIdx.x * 8 + (tidx() >> 6), (int)gridDim.x * 8); return;
  }
  const int layer = (ph - 2) / 13, s = (ph - 2) % 13;
  const float* modl = (const float*)(WSP(p) + OFF_MOD) + (size_t)layer * 5 * 9216;
  const bool last = layer == 1;
  switch (s) {
    case 0: if (EN(1)) phase_modnorm(p, layer, 0, layer == 0, TT, layer == 1); break;
    case 1:
      if (EN(2)) {
        const bf16_t* W = (const bf16_t*)(WSP(p) + OFF_W13) + (size_t)(layer * 2 + 0) * 5632 * DM;
        gemm8(H, W, TL, 5632, DM, Epi8Up{BIG}, smem);
        gemm_phase(H + (size_t)TL * DM, DM, W, DM, TC, 5632, 0, nullptr, EpiUp{BIG + (size_t)TL * DFF}, smem);
      }
      break;
    case 2:
      if (EN(3)) ffn_down_phase(p, BIG, (const bf16_t*)(WSP(p) + OFF_W2) + (size_t)(layer * 2 + 0) * DM * DFF, modl, 2, layer == 0, true, smem);
      break;
    case 3: if (EN(1)) phase_modnorm(p, layer, 1, false, TT, true); break;
    case 4:
      if (!EN(4)) break;
      if (!last) gemm8(H, (const bf16_t*)(WSP(p) + OFF_WABIN), TT, 3328, DM, Epi8InAB{BIG, (float*)(WSP(p) + OFF_DT), PRM(p, ssd_dt_bias)}, smem);
      else gemm8(H, (const bf16_t*)(WSP(p) + OFF_WCDIN), TT, 2560, DM, Epi8Bf{BIG, 2560}, smem);
      break;
    case 5: if (EN(5)) { phase_mixprep(p, layer); if (last) phase_vt(p, smem); } break;
    case 6:
      if (!last) {
        for (int u = blockIdx.x; u < 2112 + 1024 + 32; u += gridDim.x) {
          if (u < 2112) { const int head = u & 7, bc = u >> 3; if (EN(6)) ssdA_unit(p, bc / 66, bc % 66, head, smem); }
          else if (u < 3136) {
            const int v = u - 2112;
            int hq = v & 1, br = v >> 1;
            if ((gridDim.x & 7) == 0) { const int x = v & 7, jx = v >> 3; hq = x & 1; br = (x >> 1) * 128 + jx; }
            if (EN(7)) na_unit(p, br >> 7, (br >> 7) * 8192 + (br & 127) * 64, hq, br & 127, smem);
          }
          else { const int v = u - 3136, hq = v & 1, qb = (v >> 1) & 3, b = v >> 3; if (EN(7)) na_unit(p, b, TL + b * 256 + qb * 64, hq, -1, smem); }
        }
      } else {
        for (int u = blockIdx.x; u < 2112; u += gridDim.x) { const int nb = u & 7, bc = u >> 3; if (EN(8)) lru_unit(p, bc / 66, bc % 66, nb, 0, smem); }
      }
      break;
    case 7: if (EN(9)) { if (!last) phase_ssdB(p); else phase_lruY(p); } break;
    case 8:
      if (!last) {
        for (int u = blockIdx.x; u < 2112; u += gridDim.x) { const int head = u & 7, bc = u >> 3; if (EN(10)) ssdC_unit(p, bc / 66, bc % 66, head, smem); }
      } else {
        for (int u = blockIdx.x; u < 512 + 2048; u += gridDim.x) {
          if (u < 512) {
            int pair = u >> 5, qb = u & 31;
            if ((gridDim.x & 7) == 0 && gridDim.x >= 256) { const int x = u & 7, jx = u >> 3; pair = (x * 2 + (jx >> 5)) & 15; qb = jx & 31; }
            if (EN(11)) diff_unit(p, pair >> 2, pair & 3, qb, smem);
          }
          else { const int v = u - 512, nb = v & 7, bc = v >> 3; if (EN(8)) lru_unit(p, bc >> 6, 2 + (bc & 63), nb, 1, smem); }
        }
      }
      break;
    case 9:
      if (!EN(12)) break;
      if (!last) {
        const float* ssq = (const float*)(WSP(p) + OFF_SSQ);
        const int gtid = blockIdx.x * NT + tidx(), gsz = gridDim.x * NT;
        for (int it = gtid; it < TT * 64; it += gsz) {
          const int row = it >> 6, c = (it & 63) * 8;
          const float* sp = ssq + (size_t)row * 16;
          const f32x4 s0 = *(const f32x4*)sp, s1 = *(const f32x4*)(sp + 4), s2 = *(const f32x4*)(sp + 8), s3 = *(const f32x4*)(sp + 12);
          const float tot = (s0[0] + s0[1] + s0[2] + s0[3]) + (s1[0] + s1[1] + s1[2] + s1[3]) + (s2[0] + s2[1] + s2[2] + s2[3]) + (s3[0] + s3[1] + s3[2] + s3[3]);
          const float rs = rsqrtf(tot * (1.f / 512.f) + EPS);
          bf16_t* hp = H + (size_t)row * DM + 512 + c;
          const u32x4 v = *(const u32x4*)hp;
          u32x4 o = {cvtpk(bflo(v.x) * rs, bfhi(v.x) * rs), cvtpk(bflo(v.y) * rs, bfhi(v.y) * rs), cvtpk(bflo(v.z) * rs, bfhi(v.z) * rs), cvtpk(bflo(v.w) * rs, bfhi(v.w) * rs)};
          *(u32x4*)hp = o;
        }
        grid_barrier(bar, ++nbar);
        gemm8(H, (const bf16_t*)(WSP(p) + OFF_WABOUT), TT, DM, DM, Epi8Res{p, modl, 5, 1.0f, false}, smem);
      }
      else gemm8(H, (const bf16_t*)(WSP(p) + OFF_WCDOUT), TL, DM, DM, Epi8Res{p, modl, 5, 1.0f, false}, smem);
      break;
    case 10: if (EN(1)) phase_modnorm(p, layer, 2, false, last ? TL : TT, false); break;
    case 11:
      if (EN(2)) {
        const bf16_t* W = (const bf16_t*)(WSP(p) + OFF_W13) + (size_t)(layer * 2 + 1) * 5632 * DM;
        gemm8(H, W, TL, 5632, DM, Epi8Up{BIG}, smem);
        if (!last) gemm_phase(H + (size_t)TL * DM, DM, W, DM, TC, 5632, 0, nullptr, EpiUp{BIG + (size_t)TL * DFF}, smem);
      }
      break;
    case 12:
      if (EN(3)) ffn_down_phase(p, BIG, (const bf16_t*)(WSP(p) + OFF_W2) + (size_t)(layer * 2 + 1) * DM * DFF, modl, 8, false, !last, smem);
      break;
  }
}


#ifndef PROBE_EMPTY
#define PROBE_EMPTY 0
#endif
__device__ __forceinline__ void grid_barrier(unsigned* bar, unsigned epoch) {
  asm volatile("s_waitcnt vmcnt(0) lgkmcnt(0)" ::: "memory");
  __syncthreads();
  if (tidx() == 0) {
    const unsigned G = gridDim.x, ng = G < 8u ? G : 8u, grp = blockIdx.x & 7u, gs = (G - grp + 7u) >> 3;
    __builtin_amdgcn_fence(__ATOMIC_RELEASE, "agent");
    asm volatile("s_waitcnt vmcnt(0)" ::: "memory");
    if (__hip_atomic_fetch_add(bar + grp * 32, 1u, __ATOMIC_RELAXED, __HIP_MEMORY_SCOPE_AGENT) + 1u == epoch * gs) {
      if (__hip_atomic_fetch_add(bar + 8 * 32, 1u, __ATOMIC_RELAXED, __HIP_MEMORY_SCOPE_AGENT) + 1u == epoch * ng) {
        for (unsigned i = 0; i < ng; ++i) __hip_atomic_store(bar + (16 + i) * 32, epoch, __ATOMIC_RELAXED, __HIP_MEMORY_SCOPE_AGENT);
      }
    }
    while (__hip_atomic_load(bar + (16 + grp) * 32, __ATOMIC_RELAXED, __HIP_MEMORY_SCOPE_AGENT) < epoch) {}
    __builtin_amdgcn_fence(__ATOMIC_ACQUIRE, "agent");
    asm volatile("s_waitcnt vmcnt(0)" ::: "memory");
  }
  __syncthreads();
}
__global__ void __launch_bounds__(512) mega(Params p, int p0, int p1) {
  extern __shared__ __attribute__((aligned(16))) char smem[];
  {
    const int key = __builtin_amdgcn_s_getreg((5 << 11) | 4) & 63;
    *(volatile int*)(smem + LDS_WTAB + key * 4) = (int)(__builtin_amdgcn_workitem_id_x() >> 6);
    __syncthreads();
  }
  cg::grid_group grid = cg::this_grid();
  if (p1 < 0) grid.sync();
  unsigned* bar = (unsigned*)(WSP(p) + OFF_BAR);
  unsigned nbar = 0;
  unsigned long long tprobe = 0;
  for (int e = 0; e < PROBE_EMPTY; ++e) grid_barrier(bar, ++nbar);
#ifndef PROBE_PH
#define PROBE_PH -1
#define PROBE_N 0
#endif
  for (int phx = p0; phx < p1 + PROBE_N; ++phx) {
    const int ph = (PROBE_PH >= 0 && phx > PROBE_PH) ? (phx - PROBE_N < PROBE_PH ? PROBE_PH : phx - PROBE_N) : phx;
#ifndef PROBE_T
#define PROBE_T -1
#endif
    unsigned long long t0 = 0;
    if (PROBE_T >= 0 && ph == PROBE_T) t0 = __builtin_amdgcn_s_memrealtime();
    run_phase(p, ph, smem, bar, nbar, PROBE_PH >= 0 && phx > PROBE_PH && phx <= PROBE_PH + PROBE_N);
    if (phx + 1 < p1 + PROBE_N) grid_barrier(bar, ++nbar);
    if (PROBE_T >= 0 && ph == PROBE_T) tprobe += __builtin_amdgcn_s_memrealtime() - t0;
  }
  if (PROBE_T >= 0 && blockIdx.x == 0) {
    const unsigned long long te = __builtin_amdgcn_s_memrealtime();
    while (__builtin_amdgcn_s_memrealtime() - te < 4ull * tprobe) __builtin_amdgcn_s_sleep(8);
  }
}

extern "C" void kernel_launch(void* const* d_in, const int* in_sizes, int n_in, void* d_out, int out_size, void* d_ws,
                              size_t ws_size, hipStream_t stream) {
  constexpr size_t kLds = 147456;
  static int grid_blocks = 0;
  if (!grid_blocks) {
    int dev = 0, cus = 0, per_cu = 0;
    (void)hipGetDevice(&dev);
    (void)hipDeviceGetAttribute(&cus, hipDeviceAttributeMultiprocessorCount, dev);
    (void)hipFuncSetAttribute((const void*)mega, hipFuncAttributeMaxDynamicSharedMemorySize, (int)kLds);
    (void)hipOccupancyMaxActiveBlocksPerMultiprocessor(&per_cu, mega, 512, kLds);
    if (per_cu < 1) per_cu = 1;
    grid_blocks = cus * per_cu;
  }
  Params p{};
  const float** pp = (const float**)&p;
  for (int i = 0; i < 34; ++i) pp[i] = (const float*)d_in[i];
  p.out = (float*)d_out;
  p.ws = (char*)d_ws;
  int p0 = 0, p1 = NPHASE;
  (void)hipMemsetAsync((char*)d_ws + OFF_BAR, 0, 4096, stream);
  void* args[] = {&p, &p0, &p1};
  hipError_t e = hipLaunchCooperativeKernel((void*)mega, dim3(grid_blocks), dim3(512), args, kLds, stream);
  if (e != hipSuccess) fprintf(stderr, "cooperative launch failed: %s (grid %d)\n", hipGetErrorString(e), grid_blocks);
}
```
